# Optimizing an MI355X kernel written in HIP

```python
import jax
import jax.numpy as jnp
from jax import lax
import numpy as np

D_MODEL = 2048
BATCH = 8
SEQ = 2048
DEPTH = 2

GRID_W = 64
CTX_LEN = 256

HA = 8
DK_A = 128
DV_A = 128
WK_A = HA * DK_A
WA = HA * DV_A
CHUNK_A = 64

POOL_WINDOWS = (2, 4, 8, 16)
N_POOL = 4
POOL_GW = 256
WB = N_POOL * POOL_GW

HQ = 8
HKV = 2
GQ = HQ // HKV
HD = 128
WC = HQ * HD
WINDOW = 128
BLOCK_Q = 128
ROPE_THETA = 10000.0

N_BRANCH = 3
BRANCH_W = 1024
D_FF = 4 * D_MODEL
N_ADA = 6
LN_EPS = 1e-5
RMS_EPS = 1e-6
ALPHA = (2.0 * DEPTH) ** 0.25
BETA = (8.0 * DEPTH) ** -0.25

COL_AQ = 0
COL_AI = COL_AQ + WK_A
COL_AG = COL_AI + WA
COL_AFF = COL_AG + WA
COL_AFB = COL_AFF + WK_A
COL_B = COL_AFB + WK_A
COL_CQ = COL_B + WB
COL_CK = COL_CQ + WC
COL_CV = COL_CK + HKV * HD
COL_GATE = COL_CV + HKV * HD
N_COLS = COL_GATE + N_BRANCH * D_MODEL

kernel_name = 'hybrid_dit_hgrn2_pool_swa_trunk'


def _layer_norm(x, g, b):
    xf = x.astype(jnp.float32)
    mu = jnp.mean(xf, -1, keepdims=True)
    var = jnp.mean(jnp.square(xf - mu), -1, keepdims=True)
    return ((xf - mu) * lax.rsqrt(var + LN_EPS)).astype(x.dtype) * g + b


def _head_rms_norm(o, g):
    B, T = o.shape[:2]
    o = o * lax.rsqrt(jnp.mean(jnp.square(o), -1, keepdims=True) + RMS_EPS)
    return o.reshape(B, T, -1).astype(g.dtype) * g


def _axial_rope(t_len):
    rows = t_len // GRID_W
    row = jnp.repeat(jnp.arange(rows, dtype=jnp.float32), GRID_W)
    col = jnp.tile(jnp.arange(GRID_W, dtype=jnp.float32), rows)
    n_freq = HD // 4
    inv_freq = ROPE_THETA ** (-jnp.arange(n_freq, dtype=jnp.float32) / n_freq)
    ang = jnp.concatenate([row[:, None] * inv_freq, col[:, None] * inv_freq], -1)
    return jnp.cos(ang), jnp.sin(ang)


def _apply_rope(x, cos, sin):
    shape = (1, x.shape[1]) + (1,) * (x.ndim - 3) + (HD // 2,)
    cos = cos.reshape(shape).astype(x.dtype)
    sin = sin.reshape(shape).astype(x.dtype)
    x1, x2 = x[..., : HD // 2], x[..., HD // 2:]
    return jnp.concatenate([x1 * cos - x2 * sin, x2 * cos + x1 * sin], -1)


def _hgrn_gates(z, lb):
    z = z.astype(jnp.float32)
    lb = lb.astype(jnp.float32)
    logf = jnp.logaddexp(jnp.log(lb), jnp.log1p(-lb) + jax.nn.log_sigmoid(z))
    k = (1.0 - lb) * jax.nn.sigmoid(-z)
    return logf, k


def _hgrn_chunk_scan(q, k, logf, v, s0):
    B, T, H, _ = q.shape
    n = T // CHUNK_A

    def chunks(a):
        a = a.astype(jnp.float32).reshape(B, n, CHUNK_A, H, a.shape[-1])
        return jnp.transpose(a, (1, 0, 3, 2, 4))

    lower = jnp.tril(jnp.ones((CHUNK_A, CHUNK_A), dtype=bool))[:, :, None]

    def step(s, inp):
        qc, kc, lfc, vc = inp
        b = jnp.cumsum(lfc, axis=-2)
        diff = b[..., :, None, :] - b[..., None, :, :]
        decay = jnp.exp(jnp.where(lower, diff, -jnp.inf))
        scores = jnp.einsum('bhtd,bhsd,bhtsd->bhts', qc, kc, decay)
        o = jnp.einsum('bhts,bhsv->bhtv', scores, vc) + jnp.einsum('bhtd,bhdv->bhtv', qc * jnp.exp(b), s)
        b_end = b[..., -1:, :]
        s_new = jnp.exp(b_end[..., 0, :])[..., None] * s + jnp.einsum('bhsd,bhsv->bhdv', kc * jnp.exp(b_end - b), vc)
        return s_new, o

    s_fin, o = lax.scan(step, s0, (chunks(q), chunks(k), chunks(logf), chunks(v)))
    o = jnp.transpose(o, (1, 0, 3, 2, 4)).reshape(B, T, H, -1)
    return o, s_fin


def _hgrn_split(u, lb_fwd, lb_bwd):
    B, T = u.shape[:2]
    q = u[..., COL_AQ:COL_AQ + WK_A].reshape(B, T, HA, DK_A)
    i = u[..., COL_AI:COL_AI + WA].reshape(B, T, HA, DV_A)
    g = u[..., COL_AG:COL_AG + WA]
    lf_f, k_f = _hgrn_gates(u[..., COL_AFF:COL_AFF + WK_A].reshape(B, T, HA, DK_A), lb_fwd.reshape(HA, DK_A))
    lf_b, k_b = _hgrn_gates(u[..., COL_AFB:COL_AFB + WK_A].reshape(B, T, HA, DK_A), lb_bwd.reshape(HA, DK_A))
    return q, i, g, lf_f, k_f, lf_b, k_b


def _hgrn_mixer(u_c, u_l, lb_fwd, lb_bwd, norm_g, need_ctx):
    qc, ic, gc, lfc_f, kc_f, lfc_b, kc_b = _hgrn_split(u_c, lb_fwd, lb_bwd)
    ql, il, gl, lfl_f, kl_f, lfl_b, kl_b = _hgrn_split(u_l, lb_fwd, lb_bwd)
    B = u_l.shape[0]
    s0 = jnp.zeros((B, HA, DK_A, DV_A), jnp.float32)
    flip = lambda a: jnp.flip(a, axis=1)
    oc_f, sc_f = _hgrn_chunk_scan(qc, kc_f, lfc_f, ic, s0)
    oc_b, sc_b = _hgrn_chunk_scan(flip(qc), flip(kc_b), flip(lfc_b), flip(ic), s0)
    ol_f, _ = _hgrn_chunk_scan(ql, kl_f, lfl_f, il, sc_f)
    ol_b, _ = _hgrn_chunk_scan(flip(ql), flip(kl_b), flip(lfl_b), flip(il), sc_b)
    y_l = _head_rms_norm(ol_f + flip(ol_b), norm_g) * jax.nn.silu(gl)
    y_c = _head_rms_norm(oc_f + flip(oc_b), norm_g) * jax.nn.silu(gc) if need_ctx else None
    return y_c, y_l


def _centred_mean(u, w):
    T = u.shape[1]
    cs = jnp.pad(jnp.cumsum(u.astype(jnp.float32), axis=1), ((0, 0), (1, 0), (0, 0)))
    t = jnp.arange(T)
    lo = jnp.clip(t - w // 2, 0, T)
    hi = jnp.clip(t + w // 2, 0, T)
    cnt = (hi - lo).astype(jnp.float32)[None, :, None]
    return ((cs[:, hi] - cs[:, lo]) / cnt).astype(u.dtype)


def _pool_mixer(u, w_grp, scale):
    B, T = u.shape[:2]
    ug = u[..., COL_B:COL_B + WB].reshape(B, T, N_POOL, POOL_GW)
    pooled = jnp.stack([_centred_mean(ug[:, :, j], w) for j, w in enumerate(POOL_WINDOWS)], axis=2)
    y = jnp.einsum('btgc,gcd->btgd', pooled - ug, w_grp).reshape(B, T, WB)
    return y * scale


def _attention_mixer(u_c, u_l, sink, need_ctx):
    B, T = u_l.shape[:2]
    nb = T // BLOCK_Q
    nw = 3 * BLOCK_Q

    def qkv(u):
        Tn = u.shape[1]
        q = u[..., COL_CQ:COL_CQ + WC].reshape(B, Tn, HKV, GQ, HD)
        k = u[..., COL_CK:COL_CK + HKV * HD].reshape(B, Tn, HKV, HD)
        v = u[..., COL_CV:COL_CV + HKV * HD].reshape(B, Tn, HKV, HD)
        return q, k, v

    qc, kc, vc = qkv(u_c)
    ql, kl, vl = qkv(u_l)
    nc = kc.shape[1]
    cos, sin = _axial_rope(T)
    ql = _apply_rope(ql, cos, sin)
    kl = _apply_rope(kl, cos, sin)
    scale = HD ** -0.5
    sink_l = sink.astype(jnp.float32).reshape(HKV, GQ)

    qb = ql.reshape(B, nb, BLOCK_Q, HKV, GQ, HD)

    def band(a):
        ap = jnp.pad(a, ((0, 0), (BLOCK_Q, BLOCK_Q), (0, 0), (0, 0))).reshape(B, nb + 2, BLOCK_Q, HKV, HD)
        return jnp.concatenate([ap[:, :-2], ap[:, 1:-1], ap[:, 2:]], axis=2)

    kw, vw = band(kl), band(vl)
    q_pos = jnp.arange(T).reshape(nb, BLOCK_Q)
    k_pos = jnp.arange(nb)[:, None] * BLOCK_Q + jnp.arange(nw)[None, :] - BLOCK_Q
    kp = k_pos[:, None, :]
    valid = (jnp.abs(q_pos[:, :, None] - kp) <= WINDOW) & (kp >= 0) & (kp < T)
    s_win = jnp.einsum('bnqkgd,bnskd->bnkgqs', qb, kw).astype(jnp.float32) * scale
    s_win = jnp.where(valid[None, :, None, None], s_win, -jnp.inf)
    s_ctx = jnp.einsum('bnqkgd,bskd->bnkgqs', qb, kc).astype(jnp.float32) * scale
    s_sink = jnp.broadcast_to(sink_l[None, None, :, :, None, None], s_ctx.shape[:-1] + (1,))
    p = jax.nn.softmax(jnp.concatenate([s_win, s_ctx, s_sink], -1), axis=-1).astype(u_l.dtype)
    o = jnp.einsum('bnkgqs,bnskd->bnqkgd', p[..., :nw], vw) + jnp.einsum('bnkgqs,bskd->bnqkgd', p[..., nw:nw + nc], vc)
    y_l = o.reshape(B, T, WC)

    y_c = None
    if need_ctx:
        s_cc = jnp.einsum('btkgd,bskd->bkgts', qc, kc).astype(jnp.float32) * scale
        s_sink_c = jnp.broadcast_to(sink_l[None, :, :, None, None], s_cc.shape[:-1] + (1,))
        p_c = jax.nn.softmax(jnp.concatenate([s_cc, s_sink_c], -1), axis=-1).astype(u_c.dtype)
        y_c = jnp.einsum('bkgts,bskd->btkgd', p_c[..., :nc], vc).reshape(B, nc, WC)
    return y_c, y_l


def _merge_branches(u, ys, w_branch, w_out):
    B, T = u.shape[:2]
    z = jnp.einsum('btjc,jcd->btjd', jnp.stack(ys, axis=2), w_branch)
    gates = jax.nn.sigmoid(u[..., COL_GATE:].reshape(B, T, N_BRANCH, D_MODEL))
    return jnp.sum(gates * z, axis=2) @ w_out


def _sq_relu_mlp(h, w1, w2):
    return jnp.square(jax.nn.relu(h @ w1)) @ w2


def _trunk_layer(xc, xl, c, c_ctx, w_ada, b_ada, w_in, lb_fwd, lb_bwd, hgrn_norm, pool_w, pool_scale,
                 attn_sink, w_branch, w_out, ln1_g, ln1_b, w_ff1, w_ff2, ln2_g, ln2_b, need_ctx):
    mod_l = (jax.nn.silu(c) @ w_ada + b_ada)[:, None, :]
    mod_c = (jax.nn.silu(c_ctx) @ w_ada + b_ada)[None, None, :]
    sh1_l, sc1_l, g1_l, sh2_l, sc2_l, g2_l = jnp.split(mod_l, N_ADA, axis=-1)
    sh1_c, sc1_c, g1_c, sh2_c, sc2_c, g2_c = jnp.split(mod_c, N_ADA, axis=-1)

    ul = (xl * (1 + sc1_l) + sh1_l) @ w_in
    uc = (xc * (1 + sc1_c) + sh1_c) @ w_in
    ya_c, ya_l = _hgrn_mixer(uc, ul, lb_fwd, lb_bwd, hgrn_norm, need_ctx)
    yc_c, yc_l = _attention_mixer(uc, ul, attn_sink, need_ctx)
    yb_l = _pool_mixer(ul, pool_w, pool_scale)
    xl = _layer_norm(ALPHA * xl + g1_l * _merge_branches(ul, (ya_l, yb_l, yc_l), w_branch, w_out), ln1_g, ln1_b)
    xl = _layer_norm(ALPHA * xl + g2_l * _sq_relu_mlp(xl * (1 + sc2_l) + sh2_l, w_ff1, w_ff2), ln2_g, ln2_b)

    if need_ctx:
        yb_c = _pool_mixer(uc, pool_w, pool_scale)
        xc = _layer_norm(ALPHA * xc + g1_c * _merge_branches(uc, (ya_c, yb_c, yc_c), w_branch, w_out), ln1_g, ln1_b)
        xc = _layer_norm(ALPHA * xc + g2_c * _sq_relu_mlp(xc * (1 + sc2_c) + sh2_c, w_ff1, w_ff2), ln2_g, ln2_b)
    return xc, xl


def setup_inputs(seed: int = 0) -> dict:
    key = jax.random.key(seed)
    ks = jax.random.split(key, 20)

    def nrm(k, shape, s):
        return jax.random.normal(k, shape, jnp.float32) * s

    return {
        'x': nrm(ks[0], (BATCH, SEQ, D_MODEL), 1.0),
        'c': nrm(ks[1], (BATCH, D_MODEL), 1.0),
        'ctx': nrm(ks[2], (BATCH, CTX_LEN, D_MODEL), 1.0),
        'c_ctx': nrm(ks[3], (D_MODEL,), 1.0),
        'w_ada': nrm(ks[4], (DEPTH, D_MODEL, N_ADA * D_MODEL), 0.3 * D_MODEL ** -0.5),
        'b_ada': nrm(ks[5], (DEPTH, N_ADA * D_MODEL), 0.02),
        'w_in': nrm(ks[6], (DEPTH, D_MODEL, N_COLS), D_MODEL ** -0.5),
        'hgrn_lb': nrm(ks[7], (DEPTH, 2, WK_A), 0.1),
        'hgrn_norm': 1.0 + nrm(ks[8], (DEPTH, WA), 0.1),
        'pool_w': nrm(ks[9], (DEPTH, N_POOL, POOL_GW, POOL_GW), POOL_GW ** -0.5),
        'pool_scale': 1.0 + nrm(ks[10], (DEPTH, WB), 0.1),
        'attn_sink': nrm(ks[11], (DEPTH, HQ), 0.5),
        'w_branch': nrm(ks[12], (DEPTH, N_BRANCH, BRANCH_W, D_MODEL), BRANCH_W ** -0.5),
        'w_out': nrm(ks[13], (DEPTH, D_MODEL, D_MODEL), BETA * D_MODEL ** -0.5),
        'ln1_g': 1.0 + nrm(ks[14], (DEPTH, D_MODEL), 0.1),
        'ln1_b': nrm(ks[15], (DEPTH, D_MODEL), 0.02),
        'w_ff1': nrm(ks[16], (DEPTH, D_MODEL, D_FF), D_MODEL ** -0.5),
        'w_ff2': nrm(ks[17], (DEPTH, D_FF, D_MODEL), BETA * D_FF ** -0.5),
        'ln2_g': 1.0 + nrm(ks[18], (DEPTH, D_MODEL), 0.1),
        'ln2_b': nrm(ks[19], (DEPTH, D_MODEL), 0.02),
    }


def reference(x, c, ctx, c_ctx, w_ada, b_ada, w_in, hgrn_lb, hgrn_norm, pool_w, pool_scale, attn_sink,
              w_branch, w_out, ln1_g, ln1_b, w_ff1, w_ff2, ln2_g, ln2_b):
    lb = jnp.cumsum(jax.nn.softmax(hgrn_lb.astype(jnp.float32), axis=0), axis=0)
    lb = lb - lb[0:1]
    xc, xl = ctx, x
    for l in range(DEPTH):
        xc, xl = _trunk_layer(xc, xl, c, c_ctx, w_ada[l], b_ada[l], w_in[l], lb[l, 0], lb[l, 1], hgrn_norm[l],
                              pool_w[l], pool_scale[l], attn_sink[l], w_branch[l], w_out[l], ln1_g[l], ln1_b[l],
                              w_ff1[l], w_ff2[l], ln2_g[l], ln2_b[l], l < DEPTH - 1)
    return xl
```

```cpp
#include <hip/hip_runtime.h>
#include <hip/hip_cooperative_groups.h>
#include <cstdio>
namespace cg = cooperative_groups;

#ifndef COOP
#define COOP 1
#endif

#define LAS __attribute__((address_space(3)))
typedef unsigned short bf16_t;
typedef short bf16x8 __attribute__((ext_vector_type(8)));
typedef short bf16x4 __attribute__((ext_vector_type(4)));
typedef float f32x4 __attribute__((ext_vector_type(4)));
typedef float f32x16 __attribute__((ext_vector_type(16)));
typedef float f32x2 __attribute__((ext_vector_type(2)));
typedef unsigned u32x4 __attribute__((ext_vector_type(4)));
typedef unsigned u32x2 __attribute__((ext_vector_type(2)));

constexpr int NT = 18432, NL = 16384, DM = 2048, NCOLS = 13824, DFF = 8192;
constexpr size_t UNIT = (size_t)NT * 1024;
constexpr int LDS_BYTES = 131072;
constexpr float ALPHA = 1.41421356237f;
constexpr float QSCALE = 0.08838834764831845f * 1.4426950408889634f;
constexpr float LOG2E = 1.4426950408889634f;
constexpr int CONV_TILES = 6912 + 1536 + 1024 + 4096 + 4096 + 64;

struct Params {
    const float *x, *c, *ctx, *c_ctx, *w_ada, *b_ada, *w_in, *hgrn_lb, *hgrn_norm, *pool_w, *pool_scale, *attn_sink,
        *w_branch, *w_out, *ln1_g, *ln1_b, *w_ff1, *w_ff2, *ln2_g, *ln2_b;
    float* out;
    bf16_t *WinT, *WbT, *WoT, *W1T, *W2T, *PwT;
    float *mod, *rope, *xc;
    bf16_t *H, *U, *Pd, *Qb;
    unsigned* bar;
    float* stats;
};

#define AS4 __attribute__((address_space(4)))
__device__ __forceinline__ int ltid() { int t = __builtin_amdgcn_workitem_id_x(); asm volatile("" : "+v"(t)); return t; }
__device__ __forceinline__ int lbid() { int t = __builtin_amdgcn_workgroup_id_x(); asm volatile("" : "+s"(t)); return t; }
__device__ __forceinline__ float shx(float v, int lane, int mask) { return __int_as_float(__builtin_amdgcn_ds_bpermute((lane ^ mask) << 2, __float_as_int(v))); }
typedef __bf16 bf16v2_t __attribute__((ext_vector_type(2)));
__device__ __forceinline__ unsigned cvt_pk_bf16(float lo, float hi) { bf16v2_t v; v.x = (__bf16)lo; v.y = (__bf16)hi; return __builtin_bit_cast(unsigned, v); }
__device__ __forceinline__ float bf_lo(unsigned w) { return __uint_as_float(w << 16); }
__device__ __forceinline__ float bf_hi(unsigned w) { return __uint_as_float(w & 0xffff0000u); }
__device__ __forceinline__ u32x4 pack8(f32x4 a, f32x4 b) { u32x4 w; w.x = cvt_pk_bf16(a.x, a.y); w.y = cvt_pk_bf16(a.z, a.w); w.z = cvt_pk_bf16(b.x, b.y); w.w = cvt_pk_bf16(b.z, b.w); return w; }
__device__ __forceinline__ void unpack8(u32x4 w, f32x4& a, f32x4& b) { a.x = bf_lo(w.x); a.y = bf_hi(w.x); a.z = bf_lo(w.y); a.w = bf_hi(w.y); b.x = bf_lo(w.z); b.y = bf_hi(w.z); b.z = bf_lo(w.w); b.w = bf_hi(w.w); }
__device__ __forceinline__ float sigmoidf_(float v) { return __builtin_amdgcn_rcpf(1.0f + __builtin_amdgcn_exp2f(v * -1.4426950408889634f)); }
__device__ __forceinline__ float* xrow_ptr(const Params& P, size_t row) { return row < NL ? P.out + row * DM : P.xc + (row - NL) * DM; }

__device__ __forceinline__ Params load_params() {
    const AS4 Params* p = (const AS4 Params*)__builtin_amdgcn_kernarg_segment_ptr(); asm volatile("" : "+s"(p));
    Params r;
    r.x = p->x; r.c = p->c; r.ctx = p->ctx; r.c_ctx = p->c_ctx; r.w_ada = p->w_ada; r.b_ada = p->b_ada; r.w_in = p->w_in; r.hgrn_lb = p->hgrn_lb; r.hgrn_norm = p->hgrn_norm; r.pool_w = p->pool_w; r.pool_scale = p->pool_scale; r.attn_sink = p->attn_sink; r.w_branch = p->w_branch; r.w_out = p->w_out; r.ln1_g = p->ln1_g; r.ln1_b = p->ln1_b; r.w_ff1 = p->w_ff1; r.w_ff2 = p->w_ff2; r.ln2_g = p->ln2_g; r.ln2_b = p->ln2_b; r.out = p->out; r.WinT = p->WinT; r.WbT = p->WbT; r.WoT = p->WoT; r.W1T = p->W1T; r.W2T = p->W2T; r.PwT = p->PwT; r.mod = p->mod; r.rope = p->rope; r.xc = p->xc; r.H = p->H; r.U = p->U; r.Pd = p->Pd; r.Qb = p->Qb; r.bar = p->bar; r.stats = p->stats;
    return r;
}

__device__ __forceinline__ void conv_tile(const Params& P, int l, int t, unsigned char* shm) {
    const float* src; bf16_t* dst; int K, N, kt, nt, perm = 0;
    if (t < 6912) { src = P.w_in + (size_t)l * 2048 * NCOLS; dst = P.WinT; K = 2048; N = NCOLS; kt = t / 216; nt = t % 216; perm = 1; }
    else if (t < 8448) { int u = t - 6912, j = u / 512; u %= 512; src = P.w_branch + ((size_t)l * 3 + j) * 1024 * 2048; dst = P.WbT + (size_t)j * 2048 * 1024; K = 1024; N = 2048; kt = u / 32; nt = u % 32; }
    else if (t < 9472) { int u = t - 8448; src = P.w_out + (size_t)l * 2048 * 2048; dst = P.WoT; K = 2048; N = 2048; kt = u / 32; nt = u % 32; }
    else if (t < 13568) { int u = t - 9472; src = P.w_ff1 + (size_t)l * 2048 * DFF; dst = P.W1T; K = 2048; N = DFF; kt = u / 128; nt = u % 128; }
    else if (t < 17664) { int u = t - 13568; src = P.w_ff2 + (size_t)l * DFF * 2048; dst = P.W2T; K = DFF; N = 2048; kt = u / 32; nt = u % 32; }
    else { int u = t - 17664, g = u / 16; u %= 16; src = P.pool_w + ((size_t)l * 4 + g) * 65536; dst = P.PwT + (size_t)g * 65536; K = 256; N = 256; kt = u / 4; nt = u % 4; }
    float* tile = (float*)shm;
    const int tid = ltid();
    float4 v[4][2];
#pragma unroll
    for (int q = 0; q < 4; ++q)
#pragma unroll
        for (int i = 0; i < 2; ++i) {
            const int r = (tid >> 4) + 32 * i, c4 = (tid & 15) * 4;
            v[q][i] = *(const float4*)(src + (size_t)(kt * 64 + r) * N + (nt + q) * 64 + c4);
        }
#pragma unroll
    for (int q = 0; q < 4; ++q)
#pragma unroll
        for (int i = 0; i < 2; ++i) {
            const int r = (tid >> 4) + 32 * i, c4 = (tid & 15) * 4; float* tp = tile + q * 4160 + r * 65 + c4;
            tp[0] = v[q][i].x; tp[1] = v[q][i].y; tp[2] = v[q][i].z; tp[3] = v[q][i].w;
        }
    __syncthreads();
#pragma unroll
    for (int q = 0; q < 4; ++q) {
        const int n = tid >> 3, kc = (tid & 7) * 8; const float* tp = tile + q * 4160;
        f32x4 a, b;
        a.x = tp[(kc + 0) * 65 + n]; a.y = tp[(kc + 1) * 65 + n]; a.z = tp[(kc + 2) * 65 + n]; a.w = tp[(kc + 3) * 65 + n];
        b.x = tp[(kc + 4) * 65 + n]; b.y = tp[(kc + 5) * 65 + n]; b.z = tp[(kc + 6) * 65 + n]; b.w = tp[(kc + 7) * 65 + n];
        int nd = (nt + q) * 64 + n;
        if (perm && nd >= 6144 && nd < 7424) {
            const int wi = nd - 6144, hd = wi >> 7, j = wi & 127;
            nd = 6144 + hd * 128 + 2 * (j & 63) + (j >> 6);
        }
        *(u32x4*)(dst + (size_t)nd * K + kt * 64 + kc) = pack8(a, b);
    }
    __syncthreads();
}

__device__ __forceinline__ void ada_item(const Params& P, int a, unsigned char* shm) {
    const int l = a / 96, j0 = (a % 96) * 128, tid = ltid(), w = tid >> 6, lane = tid & 63;
    float* sc = (float*)shm; float* red = sc + 9 * 2048;
    for (int idx = tid; idx < 9 * 2048; idx += 512) { const int r = idx >> 11, k = idx & 2047; const float cv = r < 8 ? P.c[r * 2048 + k] : P.c_ctx[k]; sc[idx] = cv / (1.0f + __expf(-cv)); }
    __syncthreads();
    f32x2 acc[9];
#pragma unroll
    for (int r = 0; r < 9; ++r) acc[r] = (f32x2){0.f, 0.f};
    const float* wp = P.w_ada + (size_t)l * 2048 * 12288 + (size_t)(w * 256) * 12288 + j0 + 2 * lane;
#pragma unroll 8
    for (int kk = 0; kk < 256; ++kk) {
        const f32x2 wv = *(const f32x2*)(wp + (size_t)kk * 12288);
#pragma unroll
        for (int r = 0; r < 9; ++r) acc[r] += wv * sc[r * 2048 + w * 256 + kk];
    }
#pragma unroll
    for (int r = 0; r < 9; ++r) { red[(w * 9 + r) * 128 + 2 * lane] = acc[r].x; red[(w * 9 + r) * 128 + 2 * lane + 1] = acc[r].y; }
    __syncthreads();
    for (int idx = tid; idx < 9 * 128; idx += 512) {
        const int r = idx >> 7, cc = idx & 127; float s = P.b_ada[l * 12288 + j0 + cc];
#pragma unroll
        for (int w2 = 0; w2 < 8; ++w2) s += red[(w2 * 9 + r) * 128 + cc];
        P.mod[(size_t)(l * 9 + r) * 12288 + j0 + cc] = s;
    }
    __syncthreads();
}

__device__ __forceinline__ void rope_item(const Params& P) {
    for (int idx = ltid(); idx < 2048; idx += 512) {
        const int pos = idx >> 5, f = idx & 31;
        const float invf = powf(10000.0f, -(float)f / 32.0f);
        const float angf = (float)pos * invf;
        double x = (double)angf; const double twopi = 6.283185307179586476925;
        x -= twopi * rint(x / twopi);
        const double x2 = x * x; double sn = x, cs = 1.0, ts = x, tc = 1.0;
        for (int k = 1; k <= 14; ++k) { tc *= -x2 / (double)((2 * k - 1) * (2 * k)); cs += tc; ts *= -x2 / (double)((2 * k) * (2 * k + 1)); sn += ts; }
        P.rope[idx] = (float)cs; P.rope[2048 + idx] = (float)sn;
    }
}

__device__ __forceinline__ void modulate0_item(const Params& P, int item) {
    const int w = ltid() >> 6, lane = ltid() & 63; const size_t row = (size_t)item * 8 + w;
    const float* src = row < NL ? P.x + row * DM : P.ctx + (row - NL) * DM;
    const int r = row < NL ? (int)(row >> 11) : 8;
    const float* sh = P.mod + (size_t)r * 12288; const float* sc = sh + 2048;
#pragma unroll
    for (int it = 0; it < 8; ++it) {
        const int col = it * 256 + lane * 4;
        const f32x4 xv = *(const f32x4*)(src + col), shv = *(const f32x4*)(sh + col), scv = *(const f32x4*)(sc + col);
        const f32x4 h = xv * (scv + 1.0f) + shv;
        u32x2 o; o.x = cvt_pk_bf16(h.x, h.y); o.y = cvt_pk_bf16(h.z, h.w);
        *(u32x2*)(P.H + row * DM + col) = o;
    }
}

__device__ __forceinline__ void ln_item(const Params& P, int item, const float* g, const float* bta, const float* modbase  , int shchunk, bool want_h, bool lazy) {
    const int w = ltid() >> 6, lane = ltid() & 63; const size_t row = (size_t)item * 8 + w;
    float* xp = xrow_ptr(P, row);
    f32x4 v[8]; float s = 0.f;
#pragma unroll
    for (int it = 0; it < 8; ++it) { v[it] = *(const f32x4*)(xp + it * 256 + lane * 4); s += v[it].x + v[it].y + v[it].z + v[it].w; }
#pragma unroll
    for (int o = 32; o >= 1; o >>= 1) s += shx(s, lane, o);
    const float mean = s * (1.0f / 2048.0f); float q = 0.f;
#pragma unroll
    for (int it = 0; it < 8; ++it) { const f32x4 d = v[it] - mean; q += d.x * d.x + d.y * d.y + d.z * d.z + d.w * d.w; }
#pragma unroll
    for (int o = 32; o >= 1; o >>= 1) q += shx(q, lane, o);
    const float rstd = rsqrtf(q * (1.0f / 2048.0f) + 1e-5f);
    if (lazy && lane == 0) { f32x2 st; st.x = mean; st.y = rstd; *(f32x2*)(P.stats + row * 2) = st; }
    const int r = row < NL ? (int)(row >> 11) : 8;
    const float* sh = modbase + (size_t)r * 12288 + shchunk * 2048; const float* sc = sh + 2048;
#pragma unroll
    for (int it = 0; it < 8; ++it) {
        const int col = it * 256 + lane * 4;
        const f32x4 y = (v[it] - mean) * rstd * *(const f32x4*)(g + col) + *(const f32x4*)(bta + col);
        if (!lazy) *(f32x4*)(xp + col) = y;
        if (want_h) {
            const f32x4 h = y * (*(const f32x4*)(sc + col) + 1.0f) + *(const f32x4*)(sh + col);
            u32x2 o; o.x = cvt_pk_bf16(h.x, h.y); o.y = cvt_pk_bf16(h.z, h.w);
            *(u32x2*)(P.H + row * DM + col) = o;
        }
    }
}

__device__ __forceinline__ void pooldiff_item(const Params& P, int item) {
    const int tid = ltid(); const size_t row = (size_t)item * 4 + (tid >> 7); const int col = (tid & 127) * 8;
    const int half = 1 << (col >> 8);
    int t, T; size_t base;
    if (row < NL) { t = (int)(row & 2047); T = 2048; base = row - t; } else { t = (int)((row - NL) & 255); T = 256; base = row - t; }
    const int lo = max(t - half, 0), hi = min(t + half, T);
    const bf16_t* ub = P.U + 5 * UNIT;
    f32x4 sa = {0.f, 0.f, 0.f, 0.f}, sb = sa;
    u32x4 wv[16];
#pragma unroll
    for (int k = 0; k < 16; ++k) { const int s = t - half + k; const bool ok = k < 2 * half && s >= 0 && s < T; wv[k] = ok ? *(const u32x4*)(ub + (base + (ok ? s : t)) * 1024 + col) : (u32x4){0u, 0u, 0u, 0u}; }
#pragma unroll
    for (int k = 0; k < 16; ++k) { f32x4 a, b; unpack8(wv[k], a, b); sa += a; sb += b; }
    f32x4 ma, mb; unpack8(*(const u32x4*)(ub + row * 1024 + col), ma, mb);
    const float inv = 1.0f / (float)(hi - lo);
    *(u32x4*)(P.Pd + row * 1024 + col) = pack8(sa * inv - ma, sb * inv - mb);
}

__device__ __forceinline__ void hgrn_final_item(const Params& P, int l, int item) {
    const int tid = ltid(); const size_t row = (size_t)item * 4 + (tid >> 7); const int col = (tid & 127) * 8;
    f32x4 fa, fb, ba, bb; unpack8(*(const u32x4*)(P.H + row * 1024 + col), fa, fb); unpack8(*(const u32x4*)(P.H + UNIT + row * 1024 + col), ba, bb);
    const f32x4 oa = fa + ba, ob = fb + bb;
    float ss = oa.x * oa.x + oa.y * oa.y + oa.z * oa.z + oa.w * oa.w + ob.x * ob.x + ob.y * ob.y + ob.z * ob.z + ob.w * ob.w;
#pragma unroll
    for (int o = 8; o >= 1; o >>= 1) ss += shx(ss, tid & 63, o);
    const float rms = rsqrtf(ss * (1.0f / 128.0f) + 1e-6f);
    bf16_t* yp = P.U + 4 * UNIT + row * 1024 + col;
    f32x4 ga, gb; unpack8(*(const u32x4*)yp, ga, gb);
    const float* ng = P.hgrn_norm + l * 1024 + col;
    *(u32x4*)yp = pack8(oa * rms * *(const f32x4*)ng * ga, ob * rms * *(const f32x4*)(ng + 4) * gb);
}

__device__ __forceinline__ void hgrn_item(const Params& P, int l, int item, unsigned char* shm) {
    const int vh = item & 1, dir = (item >> 1) & 1, h = (item >> 2) & 7, b = item >> 5;
    const int tid = ltid(), w = tid >> 6, lane = tid & 63;
    const bf16_t* Uq = P.U; const bf16_t* Ui = P.U + UNIT; const bf16_t* Kd = P.U + (2 + dir) * UNIT;
    bf16_t* O = P.H + (size_t)dir * UNIT;
    float* qs = (float*)shm; float* ks = qs + 32 * 128; float* vs = ks + 32 * 128; float* po = vs + 32 * 64;
    const int stok = tid >> 4, sch = tid & 15, vtok = (tid >> 3) & 31, vch = tid & 7;
    f32x4 omla, omlb;
    {
        float t8[8];
#pragma unroll
        for (int e = 0; e < 8; ++e) {
            const int j = dir * 1024 + h * 128 + sch * 8 + e;
            t8[e] = (l == 0) ? 1.0f : 1.0f - 1.0f / (1.0f + __expf(P.hgrn_lb[j] - P.hgrn_lb[2048 + j]));
        }
        omla = (f32x4){t8[0], t8[1], t8[2], t8[3]}; omlb = (f32x4){t8[4], t8[5], t8[6], t8[7]};
    }
    auto rowof = [&](int s) -> size_t {
        if (s < 256) return (size_t)NL + b * 256 + (dir ? 255 - s : s);
        const int u = s - 256; return (size_t)b * 2048 + (dir ? 2047 - u : u);
    };
    f32x2 S[8];
#pragma unroll
    for (int i = 0; i < 8; ++i) S[i] = (f32x2){0.f, 0.f};
    u32x4 rq, rk, rv = {0u, 0u, 0u, 0u};
    {
        const size_t r0 = rowof(stok);
        rq = *(const u32x4*)(Uq + r0 * 1024 + h * 128 + sch * 8); rk = *(const u32x4*)(Kd + r0 * 1024 + h * 128 + sch * 8);
        if (tid < 256) rv = *(const u32x4*)(Ui + rowof(vtok) * 1024 + h * 128 + vh * 64 + vch * 8);
    }
    for (int bt = 0; bt < 72; ++bt) {
        __syncthreads();
        {
            f32x4 a, c; unpack8(rq, a, c); *(f32x4*)(qs + stok * 128 + sch * 8) = a; *(f32x4*)(qs + stok * 128 + sch * 8 + 4) = c;
            unpack8(rk, a, c); *(f32x4*)(ks + stok * 128 + sch * 8) = a * omla; *(f32x4*)(ks + stok * 128 + sch * 8 + 4) = c * omlb;
            if (tid < 256) { unpack8(rv, a, c); *(f32x4*)(vs + vtok * 64 + vch * 8) = a; *(f32x4*)(vs + vtok * 64 + vch * 8 + 4) = c; }
        }
        __syncthreads();
        if (bt + 1 < 72) {
            const size_t r0 = rowof((bt + 1) * 32 + stok);
            rq = *(const u32x4*)(Uq + r0 * 1024 + h * 128 + sch * 8); rk = *(const u32x4*)(Kd + r0 * 1024 + h * 128 + sch * 8);
            if (tid < 256) rv = *(const u32x4*)(Ui + rowof((bt + 1) * 32 + vtok) * 1024 + h * 128 + vh * 64 + vch * 8);
        }
#pragma unroll 2
        for (int tok = 0; tok < 32; ++tok) {
            const f32x4* q4 = (const f32x4*)(qs + tok * 128 + w * 16); const f32x4* k4 = (const f32x4*)(ks + tok * 128 + w * 16);
            const f32x4 qa = q4[0], qb = q4[1], qc = q4[2], qd = q4[3], ka = k4[0], kb = k4[1], kc = k4[2], kd = k4[3];
            const float v = vs[tok * 64 + lane]; const f32x2 vv = {v, v};
            f32x2 o2;
            S[0] += (f32x2){ka.x, ka.y} * (vv - S[0]); o2 = S[0] * (f32x2){qa.x, qa.y};
            S[1] += (f32x2){ka.z, ka.w} * (vv - S[1]); o2 += S[1] * (f32x2){qa.z, qa.w};
            S[2] += (f32x2){kb.x, kb.y} * (vv - S[2]); o2 += S[2] * (f32x2){qb.x, qb.y};
            S[3] += (f32x2){kb.z, kb.w} * (vv - S[3]); o2 += S[3] * (f32x2){qb.z, qb.w};
            S[4] += (f32x2){kc.x, kc.y} * (vv - S[4]); o2 += S[4] * (f32x2){qc.x, qc.y};
            S[5] += (f32x2){kc.z, kc.w} * (vv - S[5]); o2 += S[5] * (f32x2){qc.z, qc.w};
            S[6] += (f32x2){kd.x, kd.y} * (vv - S[6]); o2 += S[6] * (f32x2){qd.x, qd.y};
            S[7] += (f32x2){kd.z, kd.w} * (vv - S[7]); o2 += S[7] * (f32x2){qd.z, qd.w};
            po[(w * 32 + tok) * 64 + lane] = o2.x + o2.y;
        }
        __syncthreads();
        {
            const int tok = tid >> 4, v4 = (tid & 15) * 4;
            f32x4 s = *(const f32x4*)(po + tok * 64 + v4);
#pragma unroll
            for (int w2 = 1; w2 < 8; ++w2) s += *(const f32x4*)(po + (w2 * 32 + tok) * 64 + v4);
            u32x2 o; o.x = cvt_pk_bf16(s.x, s.y); o.y = cvt_pk_bf16(s.z, s.w);
            *(u32x2*)(O + rowof(bt * 32 + tok) * 1024 + h * 128 + vh * 64 + v4) = o;
        }
    }
    __syncthreads();
}

__device__ __forceinline__ unsigned short f2bf1(float x) { return (unsigned short)(cvt_pk_bf16(x, 0.f) & 0xffffu); }
__device__ __forceinline__ void hgrn_chunk_item(const Params& P, int l, int item, unsigned char* shm) {
    const int vh = item & 1, dir = (item >> 1) & 1, h = (item >> 2) & 7, b = item >> 5;
    const int tid = ltid(), w = tid >> 6, lane = tid & 63, ql = lane & 31, hh = lane >> 5;
    const bf16_t* Uq = P.U + h * 128; const bf16_t* Ui = P.U + UNIT + h * 128 + vh * 64; const bf16_t* Kd = P.U + (2 + dir) * UNIT + h * 128;
    bf16_t* O = P.H + (size_t)dir * UNIT + h * 128 + vh * 64;
    bf16_t* Qt = (bf16_t*)shm;
    bf16_t* Kt = Qt + 32 * 136;
    bf16_t* KhT = Kt + 32 * 136;
    bf16_t* Vt = KhT + 128 * 40;
    bf16_t* St = Vt + 64 * 40;
    float* bC = (float*)(St + 64 * 136);
    float* tot = bC + 128;
    const int d = tid & 127, tq = tid >> 7, vv = tid & 63, tg = tid >> 6;
    float oml;
    { const int j = dir * 1024 + h * 128 + d; oml = (l == 0) ? 1.0f : 1.0f - 1.0f / (1.0f + __expf(P.hgrn_lb[j] - P.hgrn_lb[2048 + j])); }
    auto rowof = [&](int s) -> size_t {
        if (s < 256) return (size_t)NL + b * 256 + (dir ? 255 - s : s);
        const int u = s - 256; return (size_t)b * 2048 + (dir ? 2047 - u : u);
    };
    unsigned short rq[8], rk[8], rv[4];
    float qf[8], kf[8], pre[8]; u32x2 vhold = {0u, 0u};
    f32x16 Sacc;
#pragma unroll
    for (int r = 0; r < 16; ++r) Sacc[r] = 0.f;
    for (int i = tid; i < 64 * 136 * 2 / 16; i += 512) ((u32x4*)St)[i] = (u32x4){0u, 0u, 0u, 0u};
    const long rstep = dir ? -1024 : 1024;
#define HG_LOAD(c) do { const bf16_t* q_ = Uq + rowof((c) * 32 + tq * 8) * 1024 + d; const bf16_t* k_ = Kd + rowof((c) * 32 + tq * 8) * 1024 + d; \
        _Pragma("unroll") for (int e = 0; e < 8; ++e) { rq[e] = q_[e * rstep]; rk[e] = k_[e * rstep]; } \
        const bf16_t* v_ = Ui + rowof((c) * 32 + tg * 4) * 1024 + vv; \
        _Pragma("unroll") for (int e = 0; e < 4; ++e) rv[e] = v_[e * rstep]; } while (0)
#define HG_STEP1() do { float run_ = 1.f; _Pragma("unroll") for (int e = 0; e < 8; ++e) { qf[e] = __uint_as_float((unsigned)rq[e] << 16); kf[e] = oml * __uint_as_float((unsigned)rk[e] << 16); \
            run_ *= fmaxf(1.0f - kf[e], 6.1e-6f); pre[e] = run_; } tot[tq * 128 + d] = run_; \
        vhold.x = (unsigned)rv[0] | ((unsigned)rv[1] << 16); vhold.y = (unsigned)rv[2] | ((unsigned)rv[3] << 16); } while (0)
#define HG_STEP2() do { const float t0_ = tot[d], t1_ = tot[128 + d], t2_ = tot[256 + d], t3_ = tot[384 + d]; \
        const float off_ = (tq > 0 ? t0_ : 1.f) * (tq > 1 ? t1_ : 1.f) * (tq > 2 ? t2_ : 1.f), pc_ = (t0_ * t1_) * (t2_ * t3_); float kh_[8]; \
        _Pragma("unroll") for (int e = 0; e < 8; ++e) { const float p_ = fmaxf(off_ * pre[e], 1e-30f), rp_ = __builtin_amdgcn_rcpf(p_), kt_ = kf[e] * rp_; \
            Qt[(tq * 8 + e) * 136 + d] = f2bf1(qf[e] * p_); Kt[(tq * 8 + e) * 136 + d] = f2bf1(kt_); kh_[e] = kt_ * pc_; } \
        *(u32x4*)(KhT + d * 40 + tq * 8) = pack8((f32x4){kh_[0], kh_[1], kh_[2], kh_[3]}, (f32x4){kh_[4], kh_[5], kh_[6], kh_[7]}); \
        if (tq == 0) bC[d] = pc_; \
        *(u32x2*)(Vt + vv * 40 + tg * 4) = vhold; } while (0)
    HG_LOAD(0);
    HG_STEP1();
    __syncthreads();
    HG_STEP2();
    HG_LOAD(1);
    for (int c = 0; c < 72; ++c) {
        __syncthreads();
        if (c + 1 < 72) { HG_STEP1(); }
        if (c + 2 < 72) { HG_LOAD(c + 2); }
        if (w < 2) {
            const int vt = w;
            f32x16 X, Ot; bf16x8 qfr[8];
#pragma unroll
            for (int r = 0; r < 16; ++r) { X[r] = 0.f; Ot[r] = 0.f; }
#pragma unroll
            for (int ks = 0; ks < 8; ++ks) {
                const bf16x8 a = *(const bf16x8*)(Kt + ql * 136 + 16 * ks + 8 * hh);
                qfr[ks] = *(const bf16x8*)(Qt + ql * 136 + 16 * ks + 8 * hh);
                X = __builtin_amdgcn_mfma_f32_32x32x16_bf16(a, qfr[ks], X, 0, 0, 0);
            }
#pragma unroll
            for (int r = 0; r < 16; ++r) { const int sidx = (r & 3) + 8 * (r >> 2) + 4 * hh; if (sidx > ql) X[r] = 0.f; }
#pragma unroll
            for (int s2 = 0; s2 < 2; ++s2) {
                u32x4 pw; pw.x = cvt_pk_bf16(X[8 * s2 + 0], X[8 * s2 + 1]); pw.y = cvt_pk_bf16(X[8 * s2 + 2], X[8 * s2 + 3]); pw.z = cvt_pk_bf16(X[8 * s2 + 4], X[8 * s2 + 5]); pw.w = cvt_pk_bf16(X[8 * s2 + 6], X[8 * s2 + 7]);
                const bf16_t* vp = Vt + (32 * vt + ql) * 40 + 16 * s2 + 4 * hh;
                const u32x2 lo = *(const u32x2*)vp, hi2 = *(const u32x2*)(vp + 8);
                u32x4 aw; aw.x = lo.x; aw.y = lo.y; aw.z = hi2.x; aw.w = hi2.y;
                Ot = __builtin_amdgcn_mfma_f32_32x32x16_bf16(__builtin_bit_cast(bf16x8, aw), __builtin_bit_cast(bf16x8, pw), Ot, 0, 0, 0);
            }
#pragma unroll
            for (int ks = 0; ks < 8; ++ks) {
                const bf16x8 a = *(const bf16x8*)(St + (32 * vt + ql) * 136 + 16 * ks + 8 * hh);
                Ot = __builtin_amdgcn_mfma_f32_32x32x16_bf16(a, qfr[ks], Ot, 0, 0, 0);
            }
            bf16_t* op = O + rowof(c * 32 + ql) * 1024 + 32 * vt + 4 * hh;
#pragma unroll
            for (int rg = 0; rg < 4; ++rg) { u32x2 o; o.x = cvt_pk_bf16(Ot[4 * rg], Ot[4 * rg + 1]); o.y = cvt_pk_bf16(Ot[4 * rg + 2], Ot[4 * rg + 3]); *(u32x2*)(op + 8 * rg) = o; }
        }
        const int vt2 = w & 1, dt = w >> 1;
        {
            const float sc = bC[32 * dt + ql];
#pragma unroll
            for (int r = 0; r < 16; ++r) Sacc[r] *= sc;
#pragma unroll
            for (int ks = 0; ks < 2; ++ks) {
                const bf16x8 a = *(const bf16x8*)(Vt + (32 * vt2 + ql) * 40 + 16 * ks + 8 * hh);
                const bf16x8 bb = *(const bf16x8*)(KhT + (32 * dt + ql) * 40 + 16 * ks + 8 * hh);
                Sacc = __builtin_amdgcn_mfma_f32_32x32x16_bf16(a, bb, Sacc, 0, 0, 0);
            }
        }
        __syncthreads();
#pragma unroll
        for (int r = 0; r < 16; ++r) St[(32 * vt2 + (r & 3) + 8 * (r >> 2) + 4 * hh) * 136 + 32 * dt + ql] = f2bf1(Sacc[r]);
        if (c + 1 < 72) { HG_STEP2(); }
    }
    __syncthreads();
#undef HG_LOAD
#undef HG_STEP1
#undef HG_STEP2
}

__device__ __forceinline__ void hgrn_chunk128_item(const Params& P, int l, int item, unsigned char* shm) {
    const int dir = item & 1, h = (item >> 1) & 7, b = item >> 4;
    const int tid = ltid(), w = tid >> 6, lane = tid & 63, ql = lane & 31, hh = lane >> 5;
    const bf16_t* Uq = P.U + h * 128; const bf16_t* Ui = P.U + UNIT + h * 128; const bf16_t* Kd = P.U + (2 + dir) * UNIT + h * 128;
    bf16_t* O = P.H + (size_t)dir * UNIT + h * 128;
    bf16_t* Qt = (bf16_t*)shm;
    bf16_t* Kt = Qt + 32 * 136;
    bf16_t* KhT = Kt + 32 * 136;
    bf16_t* Vt = KhT + 128 * 40;
    bf16_t* St = Vt + 128 * 40;
    float* bC = (float*)(St + 128 * 136);
    float* tot = bC + 128;
    const int d = tid & 127, tq = tid >> 7, vv = d, tg = tq;
    float oml;
    { const int j = dir * 1024 + h * 128 + d; oml = (l == 0) ? 1.0f : 1.0f - 1.0f / (1.0f + __expf(P.hgrn_lb[j] - P.hgrn_lb[2048 + j])); }
    auto rowof = [&](int s) -> size_t {
        if (s < 256) return (size_t)NL + b * 256 + (dir ? 255 - s : s);
        const int u = s - 256; return (size_t)b * 2048 + (dir ? 2047 - u : u);
    };
    unsigned short rq[8], rk[8], rv[8];
    float qf[8], kf[8], pre[8]; u32x4 vhold = {0u, 0u, 0u, 0u};
    f32x16 Sacc, Sacc1;
#pragma unroll
    for (int r = 0; r < 16; ++r) { Sacc[r] = 0.f; Sacc1[r] = 0.f; }
    for (int i = tid; i < 128 * 136 * 2 / 16; i += 512) ((u32x4*)St)[i] = (u32x4){0u, 0u, 0u, 0u};
    const long rstep = dir ? -1024 : 1024;
#define HG_LOAD(c) do { const bf16_t* q_ = Uq + rowof((c) * 32 + tq * 8) * 1024 + d; const bf16_t* k_ = Kd + rowof((c) * 32 + tq * 8) * 1024 + d; \
        _Pragma("unroll") for (int e = 0; e < 8; ++e) { rq[e] = q_[e * rstep]; rk[e] = k_[e * rstep]; } \
        const bf16_t* v_ = Ui + rowof((c) * 32 + tg * 8) * 1024 + vv; \
        _Pragma("unroll") for (int e = 0; e < 8; ++e) rv[e] = v_[e * rstep]; } while (0)
#define HG_STEP1() do { float run_ = 1.f; _Pragma("unroll") for (int e = 0; e < 8; ++e) { qf[e] = __uint_as_float((unsigned)rq[e] << 16); kf[e] = oml * __uint_as_float((unsigned)rk[e] << 16); \
            run_ *= fmaxf(1.0f - kf[e], 6.1e-6f); pre[e] = run_; } tot[tq * 128 + d] = run_; \
        vhold.x = (unsigned)rv[0] | ((unsigned)rv[1] << 16); vhold.y = (unsigned)rv[2] | ((unsigned)rv[3] << 16); vhold.z = (unsigned)rv[4] | ((unsigned)rv[5] << 16); vhold.w = (unsigned)rv[6] | ((unsigned)rv[7] << 16); } while (0)
#define HG_STEP2() do { const float t0_ = tot[d], t1_ = tot[128 + d], t2_ = tot[256 + d], t3_ = tot[384 + d]; \
        const float off_ = (tq > 0 ? t0_ : 1.f) * (tq > 1 ? t1_ : 1.f) * (tq > 2 ? t2_ : 1.f), pc_ = (t0_ * t1_) * (t2_ * t3_); float kh_[8]; \
        _Pragma("unroll") for (int e = 0; e < 8; ++e) { const float p_ = fmaxf(off_ * pre[e], 1e-30f), rp_ = __builtin_amdgcn_rcpf(p_), kt_ = kf[e] * rp_; \
            Qt[(tq * 8 + e) * 136 + d] = f2bf1(qf[e] * p_); Kt[(tq * 8 + e) * 136 + d] = f2bf1(kt_); kh_[e] = kt_ * pc_; } \
        *(u32x4*)(KhT + d * 40 + tq * 8) = pack8((f32x4){kh_[0], kh_[1], kh_[2], kh_[3]}, (f32x4){kh_[4], kh_[5], kh_[6], kh_[7]}); \
        if (tq == 0) bC[d] = pc_; \
        *(u32x4*)(Vt + vv * 40 + tg * 8) = vhold; } while (0)
    HG_LOAD(0);
    HG_STEP1();
    __syncthreads();
    HG_STEP2();
    HG_LOAD(1);
    for (int c = 0; c < 72; ++c) {
        __syncthreads();
        if (c + 1 < 72) { HG_STEP1(); }
        if (c + 2 < 72) { HG_LOAD(c + 2); }
        if (w < 4) {
            const int vt = w;
            f32x16 X, Ot; bf16x8 qfr[8];
#pragma unroll
            for (int r = 0; r < 16; ++r) { X[r] = 0.f; Ot[r] = 0.f; }
#pragma unroll
            for (int ks = 0; ks < 8; ++ks) {
                const bf16x8 a = *(const bf16x8*)(Kt + ql * 136 + 16 * ks + 8 * hh);
                qfr[ks] = *(const bf16x8*)(Qt + ql * 136 + 16 * ks + 8 * hh);
                X = __builtin_amdgcn_mfma_f32_32x32x16_bf16(a, qfr[ks], X, 0, 0, 0);
            }
#pragma unroll
            for (int r = 0; r < 16; ++r) { const int sidx = (r & 3) + 8 * (r >> 2) + 4 * hh; if (sidx > ql) X[r] = 0.f; }
#pragma unroll
            for (int s2 = 0; s2 < 2; ++s2) {
                u32x4 pw; pw.x = cvt_pk_bf16(X[8 * s2 + 0], X[8 * s2 + 1]); pw.y = cvt_pk_bf16(X[8 * s2 + 2], X[8 * s2 + 3]); pw.z = cvt_pk_bf16(X[8 * s2 + 4], X[8 * s2 + 5]); pw.w = cvt_pk_bf16(X[8 * s2 + 6], X[8 * s2 + 7]);
                const bf16_t* vp = Vt + (32 * vt + ql) * 40 + 16 * s2 + 4 * hh;
                const u32x2 lo = *(const u32x2*)vp, hi2 = *(const u32x2*)(vp + 8);
                u32x4 aw; aw.x = lo.x; aw.y = lo.y; aw.z = hi2.x; aw.w = hi2.y;
                Ot = __builtin_amdgcn_mfma_f32_32x32x16_bf16(__builtin_bit_cast(bf16x8, aw), __builtin_bit_cast(bf16x8, pw), Ot, 0, 0, 0);
            }
#pragma unroll
            for (int ks = 0; ks < 8; ++ks) {
                const bf16x8 a = *(const bf16x8*)(St + (32 * vt + ql) * 136 + 16 * ks + 8 * hh);
                Ot = __builtin_amdgcn_mfma_f32_32x32x16_bf16(a, qfr[ks], Ot, 0, 0, 0);
            }
            bf16_t* op = O + rowof(c * 32 + ql) * 1024 + 32 * vt + 4 * hh;
#pragma unroll
            for (int rg = 0; rg < 4; ++rg) { u32x2 o; o.x = cvt_pk_bf16(Ot[4 * rg], Ot[4 * rg + 1]); o.y = cvt_pk_bf16(Ot[4 * rg + 2], Ot[4 * rg + 3]); *(u32x2*)(op + 8 * rg) = o; }
        }
        const int dt = w & 3, vtA = (w >> 2) * 2;
        {
            const float sc = bC[32 * dt + ql];
#pragma unroll
            for (int r = 0; r < 16; ++r) { Sacc[r] *= sc; Sacc1[r] *= sc; }
#pragma unroll
            for (int ks = 0; ks < 2; ++ks) {
                const bf16x8 bb = *(const bf16x8*)(KhT + (32 * dt + ql) * 40 + 16 * ks + 8 * hh);
                const bf16x8 a0 = *(const bf16x8*)(Vt + (32 * vtA + ql) * 40 + 16 * ks + 8 * hh);
                const bf16x8 a1 = *(const bf16x8*)(Vt + (32 * vtA + 32 + ql) * 40 + 16 * ks + 8 * hh);
                Sacc = __builtin_amdgcn_mfma_f32_32x32x16_bf16(a0, bb, Sacc, 0, 0, 0);
                Sacc1 = __builtin_amdgcn_mfma_f32_32x32x16_bf16(a1, bb, Sacc1, 0, 0, 0);
            }
        }
        __syncthreads();
#pragma unroll
        for (int r = 0; r < 16; ++r) {
            St[(32 * vtA + (r & 3) + 8 * (r >> 2) + 4 * hh) * 136 + 32 * dt + ql] = f2bf1(Sacc[r]);
            St[(32 * vtA + 32 + (r & 3) + 8 * (r >> 2) + 4 * hh) * 136 + 32 * dt + ql] = f2bf1(Sacc1[r]);
        }
        if (c + 1 < 72) { HG_STEP2(); }
    }
    __syncthreads();
#undef HG_LOAD
#undef HG_STEP1
#undef HG_STEP2
}

__device__ __forceinline__ void attn_item(const Params& P, int l, int item, unsigned char* shm) {
    int b, qb, kvh; bool isctx;
    if (item < 512) { b = item >> 6; qb = (item >> 1) & 31; kvh = item & 1; isctx = false; }
    else { const int it = item - 512; b = it >> 3; qb = (it >> 1) & 3; kvh = it & 1; isctx = true; }
    const int tid = ltid(), w = tid >> 6, lane = tid & 63, g = w >> 1, qsub = w & 1, ql = lane & 31, hh = lane >> 5;
    const int hq = kvh * 4 + g, tq = qb * 64 + qsub * 32 + ql;
    const size_t qrow = isctx ? (size_t)NL + b * 256 + tq : (size_t)b * 2048 + tq;
    const bf16_t* qp = P.Qb + qrow * 1024 + hq * 128;
    bf16_t* yp = P.U + 6 * UNIT + qrow * 1024 + hq * 128;
    const bf16_t* KV = P.U + 7 * UNIT;
    bf16x8 qf[8];
#pragma unroll
    for (int s = 0; s < 8; ++s) qf[s] = *(const bf16x8*)(qp + 16 * s + 8 * hh);
    float m = P.attn_sink[l * 8 + hq] * LOG2E, lsum = hh == 0 ? 1.0f : 0.0f;
    f32x16 O[4];
#pragma unroll
    for (int dt = 0; dt < 4; ++dt)
#pragma unroll
        for (int r = 0; r < 16; ++r) O[dt][r] = 0.f;
    int nlat = 0, kt0 = 0;
    if (!isctx) { const int lo = max(0, qb * 64 - 128), hi = min(2047, qb * 64 + 63 + 128); kt0 = lo >> 5; nlat = (hi >> 5) - kt0 + 1; }
    const int ntile = nlat + 8;
    const int skey = tid >> 4, sch = tid & 15;
    bf16_t* KsB = (bf16_t*)shm;
    bf16_t* VtB = KsB + 2 * 32 * 136;
    auto krow = [&](int i) -> size_t { return i < nlat ? (size_t)b * 2048 + (kt0 + i) * 32 + skey : (size_t)NL + b * 256 + (i - nlat) * 32 + skey; };
    u32x4 rk, rv;
    { const size_t r0 = krow(0); rk = *(const u32x4*)(KV + r0 * 512 + kvh * 128 + sch * 8); rv = *(const u32x4*)(KV + r0 * 512 + 256 + kvh * 128 + sch * 8); }
    for (int i = 0; i < ntile; ++i) {
        bf16_t* Ks = KsB + (i & 1) * 32 * 136; bf16_t* Vt = VtB + (i & 1) * 128 * 36;
        *(u32x4*)(Ks + skey * 136 + sch * 8) = rk;
        {
            bf16_t* vp = Vt + (sch * 8) * 36 + skey;
            vp[0 * 36] = (bf16_t)(rv.x & 0xffff); vp[1 * 36] = (bf16_t)(rv.x >> 16); vp[2 * 36] = (bf16_t)(rv.y & 0xffff); vp[3 * 36] = (bf16_t)(rv.y >> 16);
            vp[4 * 36] = (bf16_t)(rv.z & 0xffff); vp[5 * 36] = (bf16_t)(rv.z >> 16); vp[6 * 36] = (bf16_t)(rv.w & 0xffff); vp[7 * 36] = (bf16_t)(rv.w >> 16);
        }
        __syncthreads();
        if (i + 1 < ntile) { const size_t r0 = krow(i + 1); rk = *(const u32x4*)(KV + r0 * 512 + kvh * 128 + sch * 8); rv = *(const u32x4*)(KV + r0 * 512 + 256 + kvh * 128 + sch * 8); }
        f32x16 S;
#pragma unroll
        for (int r = 0; r < 16; ++r) S[r] = 0.f;
#pragma unroll
        for (int s = 0; s < 8; ++s) {
            const bf16x8 a = *(const bf16x8*)(Ks + ql * 136 + 16 * s + 8 * hh);
            S = __builtin_amdgcn_mfma_f32_32x32x16_bf16(a, qf[s], S, 0, 0, 0);
        }
        if (i < nlat) {
            const int kbase = (kt0 + i) * 32 + 4 * hh;
#pragma unroll
            for (int r = 0; r < 16; ++r) { const int sk = kbase + (r & 3) + 8 * (r >> 2); const int d = tq - sk; if (d > 128 || d < -128) S[r] = -INFINITY; }
        }
        float mt = S[0];
#pragma unroll
        for (int r = 1; r < 16; ++r) mt = fmaxf(mt, S[r]);
        mt = fmaxf(mt, shx(mt, lane, 32));
        const float mnew = fmaxf(m, mt), alpha = exp2f(m - mnew); m = mnew;
        float ps = 0.f;
#pragma unroll
        for (int r = 0; r < 16; ++r) { S[r] = exp2f(S[r] - mnew); ps += S[r]; }
        lsum = lsum * alpha + ps;
#pragma unroll
        for (int dt = 0; dt < 4; ++dt)
#pragma unroll
            for (int r = 0; r < 16; ++r) O[dt][r] *= alpha;
        bf16x8 pf[2];
#pragma unroll
        for (int s2 = 0; s2 < 2; ++s2) {
            u32x4 pw; pw.x = cvt_pk_bf16(S[8 * s2 + 0], S[8 * s2 + 1]); pw.y = cvt_pk_bf16(S[8 * s2 + 2], S[8 * s2 + 3]); pw.z = cvt_pk_bf16(S[8 * s2 + 4], S[8 * s2 + 5]); pw.w = cvt_pk_bf16(S[8 * s2 + 6], S[8 * s2 + 7]);
            pf[s2] = __builtin_bit_cast(bf16x8, pw);
        }
#pragma unroll
        for (int dt = 0; dt < 4; ++dt)
#pragma unroll
            for (int s2 = 0; s2 < 2; ++s2) {
                const bf16_t* vp = Vt + (32 * dt + ql) * 36 + 16 * s2 + 4 * hh;
                const u32x2 lo = *(const u32x2*)vp, hi2 = *(const u32x2*)(vp + 8);
                u32x4 aw; aw.x = lo.x; aw.y = lo.y; aw.z = hi2.x; aw.w = hi2.y;
                O[dt] = __builtin_amdgcn_mfma_f32_32x32x16_bf16(__builtin_bit_cast(bf16x8, aw), pf[s2], O[dt], 0, 0, 0);
            }
    }
    const float ltot = lsum + shx(lsum, lane, 32), inv = 1.0f / ltot;
#pragma unroll
    for (int dt = 0; dt < 4; ++dt)
#pragma unroll
        for (int rg = 0; rg < 4; ++rg) {
            u32x2 o; o.x = cvt_pk_bf16(O[dt][4 * rg] * inv, O[dt][4 * rg + 1] * inv); o.y = cvt_pk_bf16(O[dt][4 * rg + 2] * inv, O[dt][4 * rg + 3] * inv);
            *(u32x2*)(yp + 32 * dt + 8 * rg + 4 * hh) = o;
        }
    __syncthreads();
}

constexpr int BM = 256, BK = 64, HALF = 128, HTB = HALF * BK * 2, NXCD = 8, WGM = 8;
__device__ __forceinline__ int lds_byte(int r, int c) { const int st = (r >> 4) * 2 + (c >> 5), rr = r & 15, cc = c & 31, ob = rr * 64 + cc * 2; return st * 1024 + (ob ^ (((ob >> 9) & 1) << 5)); }
__device__ __forceinline__ void stage_rc(int b, int& R, int& C) { const int st = b / 1024, sb = b % 1024, swz = sb ^ (((sb >> 9) & 1) << 5); R = (st >> 1) * 16 + swz / 64; C = (st & 1) * 32 + (swz % 64) / 2; }
__device__ __forceinline__ int perm32(int rho) { const int n = rho >> 4, i = rho & 15; return 8 * (i >> 2) + 4 * n + (i & 3); }

enum { MODE_U = 0, MODE_POOL = 1, MODE_BRANCH = 2, MODE_RES1 = 3, MODE_FF1 = 4, MODE_RES2 = 5 };
struct Unit { int pm, pn, z; };
template <int MODE> struct GCfg;
template <> struct GCfg<MODE_U>      { static constexpr int lda = 2048, ldb = 2048, nN = NCOLS / 256, nZ = 1, zseq = 0, K = 2048; static constexpr size_t sAz = 0, sBz = 0; };
template <> struct GCfg<MODE_POOL>   { static constexpr int lda = 1024, ldb = 256, nN = 1, nZ = 4, zseq = 0, K = 256; static constexpr size_t sAz = 256, sBz = 65536; };
template <> struct GCfg<MODE_BRANCH> { static constexpr int lda = 1024, ldb = 1024, nN = 8, nZ = 3, zseq = 1, K = 1024; static constexpr size_t sAz = UNIT, sBz = (size_t)2048 * 1024; };
template <> struct GCfg<MODE_RES1>   { static constexpr int lda = 2048, ldb = 2048, nN = 8, nZ = 1, zseq = 0, K = 2048; static constexpr size_t sAz = 0, sBz = 0; };
template <> struct GCfg<MODE_FF1>    { static constexpr int lda = 2048, ldb = 2048, nN = DFF / 256, nZ = 1, zseq = 0, K = 2048; static constexpr size_t sAz = 0, sBz = 0; };
template <> struct GCfg<MODE_RES2>   { static constexpr int lda = DFF, ldb = DFF, nN = 8, nZ = 1, zseq = 0, K = DFF; static constexpr size_t sAz = 0, sBz = 0; };
template <int MODE> __device__ __forceinline__ bool next_unit(int nM, int i, int G, int c, Unit& u) {
    typedef GCfg<MODE> C;
    if (MODE == MODE_U && nM == 64) {
        const long L = (long)i * G + c;
        if (L >= 3456) {
            if (L >= 3568) return false;
            const int idx = (int)L - 3456, k = idx >> 3;
            u.pm = 64 + (idx & 7); u.pn = k < 4 ? 4 + k : (k < 12 ? 12 + (k - 4) : 28 + (k - 12)); u.z = 0; return true;
        }
    }
    constexpr int nNe = C::zseq ? C::nN : C::nN * C::nZ; const int nwg = nM * nNe;
    const int ti = C::zseq ? i / C::nZ : i;
    const long L = (long)ti * G + c; if (L >= nwg) return false;
    int wgid = (int)L; { const int q = nwg / NXCD, r = nwg % NXCD, xcd = wgid % NXCD, off = wgid / NXCD; wgid = (xcd < r ? xcd * (q + 1) : r * (q + 1) + (xcd - r) * q) + off; }
    const int nig = WGM * nNe, gid = wgid / nig, fm = gid * WGM, gsz = (nM - fm) < WGM ? (nM - fm) : WGM;
    u.pm = fm + ((wgid % nig) % gsz); const int pne = (wgid % nig) / gsz;
    if (C::zseq) { u.pn = pne; u.z = i % C::nZ; } else { u.pn = pne % C::nN; u.z = pne / C::nN; }
    return true;
}

template <int MODE> __device__ __forceinline__ void epilogue(const int l_in, const Unit& u_in, f32x4 (&acc)[2][2][4][2], int wr, int wc, int fr, int fq) {
    const AS4 Params* Pp = (const AS4 Params*)__builtin_amdgcn_kernarg_segment_ptr();
    int pm = u_in.pm, pn = u_in.pn, z = u_in.z, l = l_in;
    asm volatile("" : "+s"(Pp), "+s"(pm), "+s"(pn), "+s"(z), "+s"(l), "+s"(wr), "+s"(wc), "+v"(fr), "+v"(fq));
    const int row0 = pm * BM + wr * 64 + fr, cl = wc * 32 + 8 * fq;
    if (MODE == MODE_U) {
        bf16_t* U = Pp->U; const float* rope = Pp->rope;
        int kind, ld, colo; bf16_t* dst;
        if (pn < 8) { kind = 0; dst = U + (size_t)(pn >> 2) * UNIT; ld = 1024; colo = (pn & 3) * 256 + cl; }
        else if (pn < 12) { kind = 1; dst = U + 4 * UNIT; ld = 1024; colo = (pn & 3) * 256 + cl; }
        else if (pn < 20) { kind = 2; dst = U + (size_t)(2 + ((pn - 12) >> 2)) * UNIT; ld = 1024; colo = (pn & 3) * 256 + cl; }
        else if (pn < 24) { kind = 0; dst = U + 5 * UNIT; ld = 1024; colo = (pn & 3) * 256 + cl; }
        else if (pn < 28) { kind = 4; dst = Pp->Qb; ld = 1024; colo = (pn & 3) * 256 + cl; }
        else if (pn == 28) { kind = 5; dst = U + 7 * UNIT; ld = 512; colo = cl; }
        else if (pn == 29) { kind = 0; dst = U + 7 * UNIT; ld = 512; colo = 256 + cl; }
        else { kind = 3; dst = U + 7 * UNIT + (size_t)NT * 512; ld = 6144; colo = (pn - 30) * 256 + cl; }
        const bool latent = pm < 64;
#pragma unroll
        for (int ai = 0; ai < 2; ++ai)
#pragma unroll
            for (int m = 0; m < 4; ++m) {
                const int row = row0 + ai * HALF + m * 16;
                f32x4 cs = {1.f, 1.f, 1.f, 1.f}, sn = {0.f, 0.f, 0.f, 0.f};
                if (kind >= 4 && latent) {
                    const int t = row & 2047, pos = wc < 2 ? (t >> 6) : (t & 63), f = (16 * wc + 4 * fq) & 31;
                    cs = *(const f32x4*)(rope + pos * 32 + f); sn = *(const f32x4*)(rope + 2048 + pos * 32 + f);
                }
#pragma unroll
                for (int bj = 0; bj < 2; ++bj) {
                    f32x4 a = acc[ai][bj][m][0], b = acc[ai][bj][m][1];
                    if (kind == 1) {
#pragma unroll
                        for (int j = 0; j < 4; ++j) { a[j] = a[j] * sigmoidf_(a[j]); b[j] = b[j] * sigmoidf_(b[j]); }
                    } else if (kind == 2) {
#pragma unroll
                        for (int j = 0; j < 4; ++j) { a[j] = sigmoidf_(-a[j]); b[j] = sigmoidf_(-b[j]); }
                    } else if (kind == 3) {
#pragma unroll
                        for (int j = 0; j < 4; ++j) { a[j] = sigmoidf_(a[j]); b[j] = sigmoidf_(b[j]); }
                    } else if (kind >= 4) {
                        f32x4 ra, rb;
                        ra.x = a.x * cs.x - a.y * sn.x; ra.y = a.y * cs.x + a.x * sn.x; ra.z = a.z * cs.y - a.w * sn.y; ra.w = a.w * cs.y + a.z * sn.y;
                        rb.x = b.x * cs.z - b.y * sn.z; rb.y = b.y * cs.z + b.x * sn.z; rb.z = b.z * cs.w - b.w * sn.w; rb.w = b.w * cs.w + b.z * sn.w;
                        a = ra; b = rb;
                        if (kind == 4) { a *= QSCALE; b *= QSCALE; }
                    }
                    *(u32x4*)(dst + (size_t)row * ld + colo + bj * HALF) = pack8(a, b);
                }
            }
    } else if (MODE == MODE_FF1) {
        bf16_t* dst = Pp->U;
#pragma unroll
        for (int ai = 0; ai < 2; ++ai)
#pragma unroll
            for (int m = 0; m < 4; ++m)
#pragma unroll
                for (int bj = 0; bj < 2; ++bj) {
                    f32x4 a = acc[ai][bj][m][0], b = acc[ai][bj][m][1];
#pragma unroll
                    for (int j = 0; j < 4; ++j) { const float x = fmaxf(a[j], 0.f), y = fmaxf(b[j], 0.f); a[j] = x * x; b[j] = y * y; }
                    *(u32x4*)(dst + (size_t)(row0 + ai * HALF + m * 16) * DFF + pn * 256 + cl + bj * HALF) = pack8(a, b);
                }
    } else if (MODE == MODE_POOL) {
        bf16_t* dst = Pp->U + 5 * UNIT; const float* ps = Pp->pool_scale + l * 1024 + z * 256 + cl;
#pragma unroll
        for (int bj = 0; bj < 2; ++bj) {
            const f32x4 s0 = *(const f32x4*)(ps + bj * HALF), s1 = *(const f32x4*)(ps + bj * HALF + 4);
#pragma unroll
            for (int ai = 0; ai < 2; ++ai)
#pragma unroll
                for (int m = 0; m < 4; ++m)
                    *(u32x4*)(dst + (size_t)(row0 + ai * HALF + m * 16) * 1024 + z * 256 + cl + bj * HALF) = pack8(acc[ai][bj][m][0] * s0, acc[ai][bj][m][1] * s1);
        }
    } else if (MODE == MODE_BRANCH) {
        bf16_t* U = Pp->U; bf16_t* Hb = Pp->H;
        const bf16_t* G = U + 7 * UNIT + (size_t)NT * 512;
#pragma unroll
        for (int ai = 0; ai < 2; ++ai)
#pragma unroll
            for (int m = 0; m < 4; ++m)
#pragma unroll
                for (int bj = 0; bj < 2; ++bj) {
                    const size_t row = row0 + ai * HALF + m * 16; const int col = pn * 256 + cl + bj * HALF;
                    f32x4 ga, gb; unpack8(*(const u32x4*)(G + row * 6144 + z * 2048 + col), ga, gb);
                    if (z < 2) {
                        f32x4 na, nb; unpack8(*(const u32x4*)(G + row * 6144 + (z + 1) * 2048 + col), na, nb);
#pragma unroll
                        for (int j = 0; j < 4; ++j) { ga[j] *= __builtin_amdgcn_rcpf(fmaxf(na[j], 1e-30f)); gb[j] *= __builtin_amdgcn_rcpf(fmaxf(nb[j], 1e-30f)); }
                        acc[ai][bj][m][0] *= ga; acc[ai][bj][m][1] *= gb;
                    } else *(u32x4*)(Hb + row * DM + col) = pack8(acc[ai][bj][m][0] * ga, acc[ai][bj][m][1] * gb);
                }
    } else {
        constexpr int chunk = MODE == MODE_RES1 ? 2 : 5;
        const int r = pm < 64 ? (pm >> 3) : 8;
        const float* gp = Pp->mod + (size_t)(l * 9 + r) * 12288 + chunk * 2048 + pn * 256 + cl;
        const bool from_input = (l == 0 && chunk == 2);
        float* xb = pm < 64 ? Pp->out : Pp->xc - (size_t)NL * DM;
        const float* xin = from_input ? (pm < 64 ? Pp->x : Pp->ctx - (size_t)NL * DM) : xb;
        const float* st = Pp->stats;
        const float* lng = (MODE == MODE_RES1 ? Pp->ln2_g + (l - 1) * 2048 : Pp->ln1_g + l * 2048) + pn * 256 + cl;
        const float* lnb = (MODE == MODE_RES1 ? Pp->ln2_b + (l - 1) * 2048 : Pp->ln1_b + l * 2048) + pn * 256 + cl;
#pragma unroll
        for (int bj = 0; bj < 2; ++bj) {
            const f32x4 g0 = *(const f32x4*)(gp + bj * HALF), g1 = *(const f32x4*)(gp + bj * HALF + 4);
            f32x4 lg0 = {1.f, 1.f, 1.f, 1.f}, lg1 = lg0, lb0 = {0.f, 0.f, 0.f, 0.f}, lb1 = lb0;
            if (!from_input) { lg0 = *(const f32x4*)(lng + bj * HALF); lg1 = *(const f32x4*)(lng + bj * HALF + 4); lb0 = *(const f32x4*)(lnb + bj * HALF); lb1 = *(const f32x4*)(lnb + bj * HALF + 4); }
#pragma unroll
            for (int ai = 0; ai < 2; ++ai)
#pragma unroll
                for (int m = 0; m < 4; ++m) {
                    const size_t row = (size_t)(row0 + ai * HALF + m * 16), o = row * DM + pn * 256 + cl + bj * HALF;
                    f32x4 x0 = *(const f32x4*)(xin + o), x1 = *(const f32x4*)(xin + o + 4);
                    if (!from_input) { const f32x2 ms = *(const f32x2*)(st + row * 2); x0 = (x0 - ms.x) * ms.y * lg0 + lb0; x1 = (x1 - ms.x) * ms.y * lg1 + lb1; }
                    *(f32x4*)(xb + o) = x0 * ALPHA + g0 * acc[ai][bj][m][0]; *(f32x4*)(xb + o + 4) = x1 * ALPHA + g1 * acc[ai][bj][m][1];
                }
        }
    }
}

template <int MODE> __device__ __forceinline__ void gemm_phase(const Params& P, LAS unsigned char* lds, const int l, const int nM, const bf16_t* gA, const bf16_t* gBt, const int pm_off = 0, const int Gv = 0, const int cv = 0) {
    typedef GCfg<MODE> C;
    const int tid = ltid(), wid = __builtin_amdgcn_readfirstlane(tid >> 6), lane = tid & 63, wr = wid >> 2, wc = wid & 3, fr = lane & 15, fq = lane >> 4;
    constexpr int K = C::K, nt = K / BK; const int G = Gv ? Gv : (int)gridDim.x, c = Gv ? cv : lbid();
    unsigned voffA[2], voffB[2];
#pragma unroll
    for (int i = 0; i < 2; ++i) { int R, Cc; stage_rc(tid * 16 + i * 8192, R, Cc); const int Rb = (R & ~31) + perm32(R & 31);
        voffA[i] = (unsigned)(R * C::lda + Cc) * 2u; voffB[i] = (unsigned)(Rb * C::ldb + Cc) * 2u; }
    const size_t kstep = (size_t)(BK * 2);
    constexpr size_t hstepA = (size_t)HALF * C::lda * 2, hstepB = (size_t)HALF * C::ldb * 2;
    const unsigned ldsw = (unsigned)wid * 1024u;
    const int aoff = lds_byte(wr * 64 + fr, fq * 8), boff = lds_byte(wc * 32 + fr, fq * 8);
#define G_SA(b, h) (((b) * 2 + (h)) * HTB)
#define G_SB(b, h) ((4 + (b) * 2 + (h)) * HTB)
#define G_STAGE(bufoff, gbase, voff) do { _Pragma("unroll") for (int _i = 0; _i < 2; ++_i) \
        __builtin_amdgcn_global_load_lds((const unsigned*)((const char*)(gbase) + (voff)[_i]), (LAS unsigned*)(lds + (bufoff) + ldsw + _i * 8192), 16, 0, 0); } while (0)
#define G_LDA(dst, b, h) do { _Pragma("unroll") for (int m = 0; m < 4; ++m) _Pragma("unroll") for (int k = 0; k < 2; ++k) dst[m][k] = *(const LAS bf16x8*)(lds + G_SA(b, h) + aoff + m * 2048 + k * 1024); } while (0)
#define G_LDB(dst, b, h) do { _Pragma("unroll") for (int n = 0; n < 2; ++n) _Pragma("unroll") for (int k = 0; k < 2; ++k) dst[n][k] = *(const LAS bf16x8*)(lds + G_SB(b, h) + boff + n * 2048 + k * 1024); } while (0)
#define G_MMA(ai, bj, At, Bt) do { __builtin_amdgcn_s_setprio(1); _Pragma("unroll") for (int m = 0; m < 4; ++m) _Pragma("unroll") for (int n = 0; n < 2; ++n) _Pragma("unroll") for (int k = 0; k < 2; ++k) \
        acc[ai][bj][m][n] = __builtin_amdgcn_mfma_f32_16x16x32_bf16(Bt[n][k], At[m][k], acc[ai][bj][m][n], 0, 0, 0); __builtin_amdgcn_s_setprio(0); } while (0)
#define G_WAIT_V(n) asm volatile("s_waitcnt vmcnt(" #n ")" ::: "memory")
#define G_WAIT_L(n) asm volatile("s_waitcnt lgkmcnt(" #n ")" ::: "memory")
#define G_BAR __builtin_amdgcn_s_barrier()
#define G_SCHED __builtin_amdgcn_sched_barrier(0)
#define G_APTR(u) ((const char*)(gA + (size_t)(u).z * C::sAz + (size_t)(u).pm * BM * C::lda))
#define G_BPTR(u) ((const char*)(gBt + (size_t)(u).z * C::sBz + (size_t)(u).pn * BM * C::ldb))
    Unit cur, nxt; int ui = 0;
    if (!next_unit<MODE>(nM, 0, G, c, cur)) return;
    cur.pm += pm_off;
    f32x4 acc[2][2][4][2];
#pragma unroll
    for (int a = 0; a < 2; ++a)
#pragma unroll
        for (int b = 0; b < 2; ++b)
#pragma unroll
            for (int m = 0; m < 4; ++m)
#pragma unroll
                for (int n = 0; n < 2; ++n) acc[a][b][m][n] = (f32x4){0.f, 0.f, 0.f, 0.f};
    bf16x8 At[4][2], B0[2][2], B1[2][2];
    const char* cA = G_APTR(cur); const char* cB = G_BPTR(cur);
    G_STAGE(G_SB(0, 0), cB, voffB); G_STAGE(G_SA(0, 0), cA, voffA); G_STAGE(G_SB(0, 1), cB + hstepB, voffB); G_STAGE(G_SA(0, 1), cA + hstepA, voffA);
    if (wr == 1) G_BAR;
    G_WAIT_V(4); G_BAR;
    G_STAGE(G_SB(1, 0), cB + kstep, voffB); G_STAGE(G_SA(1, 0), cA + kstep, voffA); G_STAGE(G_SB(1, 1), cB + hstepB + kstep, voffB);
    G_WAIT_V(6); G_BAR;
    for (;;) {
        const bool has_next = next_unit<MODE>(nM, ui + 1, G, c, nxt); nxt.pm += pm_off;
        const char* nA = has_next ? G_APTR(nxt) : cA; const char* nB = has_next ? G_BPTR(nxt) : cB;
        for (int t = 0; t < nt; t += 2) {
            const bool last = (t == nt - 2);
            const char* a1 = cA + (size_t)(t + 1) * kstep;
            const char* a2 = last ? nA : cA + (size_t)(t + 2) * kstep; const char* b2 = last ? nB : cB + (size_t)(t + 2) * kstep;
            const char* a3 = a2 + kstep; const char* b3 = b2 + kstep;
            G_LDB(B0, 0, 0); G_SCHED; G_LDA(At, 0, 0); G_STAGE(G_SA(1, 1), a1 + hstepA, voffA);
            G_WAIT_L(8); G_BAR; G_WAIT_L(0); G_MMA(0, 0, At, B0); G_BAR; G_SCHED;
            G_LDB(B1, 0, 1); G_STAGE(G_SB(0, 0), b2, voffB);
            G_BAR; G_WAIT_L(0); G_MMA(0, 1, At, B1); G_BAR;
            G_LDA(At, 0, 1); G_STAGE(G_SA(0, 0), a2, voffA);
            G_BAR; G_WAIT_L(0); G_MMA(1, 0, At, B0); G_BAR; G_SCHED;
            G_STAGE(G_SB(0, 1), b2 + hstepB, voffB);
            G_WAIT_V(6); G_BAR; G_MMA(1, 1, At, B1); G_BAR;
            G_LDB(B0, 1, 0); G_SCHED; G_LDA(At, 1, 0); G_STAGE(G_SA(0, 1), a2 + hstepA, voffA);
            G_WAIT_L(8); G_BAR; G_WAIT_L(0); G_MMA(0, 0, At, B0); G_BAR; G_SCHED;
            G_LDB(B1, 1, 1); G_STAGE(G_SB(1, 0), b3, voffB);
            G_BAR; G_WAIT_L(0); G_MMA(0, 1, At, B1); G_BAR;
            G_LDA(At, 1, 1); G_STAGE(G_SA(1, 0), a3, voffA);
            G_BAR; G_WAIT_L(0); G_MMA(1, 0, At, B0); G_BAR; G_SCHED;
            G_STAGE(G_SB(1, 1), b3 + hstepB, voffB);
            G_WAIT_V(6); G_BAR; G_MMA(1, 1, At, B1); G_BAR;
        }
        epilogue<MODE>(l, cur, acc, wr, wc, fr, fq);
        if (!has_next) break;
        if (!(MODE == MODE_BRANCH && cur.z < 2)) {
#pragma unroll
            for (int a = 0; a < 2; ++a)
#pragma unroll
                for (int b = 0; b < 2; ++b)
#pragma unroll
                    for (int m = 0; m < 4; ++m)
#pragma unroll
                        for (int n = 0; n < 2; ++n) acc[a][b][m][n] = (f32x4){0.f, 0.f, 0.f, 0.f};
        }
        cur = nxt; cA = nA; cB = nB; ++ui;
    }
    G_WAIT_V(0);
    if (wr == 0) G_BAR;
    G_BAR;
#undef G_SA
#undef G_SB
#undef G_STAGE
#undef G_LDA
#undef G_LDB
#undef G_MMA
#undef G_WAIT_V
#undef G_WAIT_L
#undef G_BAR
#undef G_SCHED
#undef G_APTR
#undef G_BPTR
}

constexpr int N_PHASES = 21;
#ifndef DUP_CV
#define DUP_CV 1
#endif
#ifndef DUP_BAR
#define DUP_BAR 1
#endif
#ifndef DUP_BR
#define DUP_BR 1
#endif
#ifndef DUP_F1
#define DUP_F1 1
#endif
__device__ __forceinline__ void run_phase(const Params& P, int ph, unsigned char* shm) {
    const int G = gridDim.x, c = lbid();
#ifndef ONLY_SP
    if (ph == 0) {
        if (c == G - 1) rope_item(P);
        for (int a = c; a < 192; a += G) ada_item(P, a, shm);
        for (int rep = 0; rep < DUP_CV; ++rep) for (int t = 4 * c; t < CONV_TILES; t += 4 * G) conv_tile(P, 0, t, shm);
        return;
    }
    if (ph == 1) { for (int it = c; it < NT / 8; it += G) modulate0_item(P, it); return; }
#endif
#ifdef ONLY_SP
    const int l = (ph - 2) / 9, sp = ONLY_SP;
#else
    const int l = ph < 12 ? 0 : 1, sp = l == 0 ? ph - 2 : (ph - 12 < 8 ? ph - 12 : 9);
#endif
    const int rows = l == 0 ? NT : NL;
    LAS unsigned char* lds = (LAS unsigned char*)shm;
#ifndef PH_MASK
#define PH_MASK 0x1ff
#endif
#define EN(k) if (!((PH_MASK >> (k)) & 1)) break;
    switch (sp) {
#ifndef DUP_UG
#define DUP_UG 1
#endif
    case 0: EN(0) for (int rep = 0; rep < DUP_UG; ++rep) gemm_phase<MODE_U>(P, lds, l, l == 0 ? NT / 256 : NL / 256, P.H, P.WinT); break;
    case 1: { EN(1)
#ifndef DUP_HGRN
#define DUP_HGRN 1
#endif
        #ifndef HGRN_CHUNK
#define HGRN_CHUNK 1
#endif
        const int nattn = l == 0 ? 576 : 512;
        if (G >= 256) {
            const int npd = rows / 4, npd_h = (npd * 80) / 100;
            if (c < 128) {
                hgrn_chunk128_item(P, l, c, shm);
                for (int it = c; it < npd_h; it += 128) pooldiff_item(P, it);
            } else {
                const int c2 = c - 128, G2 = G - 128;
                for (int it = c2; it < nattn; it += G2) attn_item(P, l, it, shm);
                for (int it = npd_h + c2; it < npd; it += G2) pooldiff_item(P, it);
            }
        } else {
            for (int it = c; it < 128; it += G) hgrn_chunk128_item(P, l, it, shm);
            for (int it = c; it < nattn; it += G) attn_item(P, l, it, shm);
            for (int it = c; it < rows / 4; it += G) pooldiff_item(P, it);
        }
    } break;
    case 2: { EN(2)
        for (int it = c; it < rows / 4; it += G) hgrn_final_item(P, l, it);
        gemm_phase<MODE_POOL>(P, lds, l, rows / 256, P.Pd, P.PwT);
    } break;
    case 3: EN(3) for (int rep = 0; rep < DUP_BR; ++rep) gemm_phase<MODE_BRANCH>(P, lds, l, rows / 256, P.U + 4 * UNIT, P.WbT); break;
    case 4: EN(4) gemm_phase<MODE_RES1>(P, lds, l, rows / 256, P.H, P.WoT); break;
    case 5: EN(5) for (int it = c; it < rows / 8; it += G) ln_item(P, it, P.ln1_g + l * 2048, P.ln1_b + l * 2048, P.mod + (size_t)l * 9 * 12288, 3, true, true); break;
    case 6: EN(6) for (int rep = 0; rep < DUP_F1; ++rep) gemm_phase<MODE_FF1>(P, lds, l, rows / 256, P.H, P.W1T); break;
    case 7: EN(7) gemm_phase<MODE_RES2>(P, lds, l, NL / 256, P.U, P.W2T); break;
    case 8: { EN(8)
        const int split = G >= 128 ? 64 : 0;
        if (split && c < split) gemm_phase<MODE_RES2>(P, lds, l, (NT - NL) / 256, P.U, P.W2T, NL / 256, split, c);
        else {
            if (!split) gemm_phase<MODE_RES2>(P, lds, l, (NT - NL) / 256, P.U, P.W2T, NL / 256);
            const int c2 = c - split, G2 = G - split;
            for (int it = c2; it < NL / 8; it += G2) ln_item(P, it, P.ln2_g + l * 2048, P.ln2_b + l * 2048, P.mod + (size_t)(l + 1) * 9 * 12288, 0, true, true);
        }
    } break;
    case 9: { EN(8)
        const bool more = l + 1 < 2;
        if (more) {
            for (int it = NL / 8 + c; it < NT / 8; it += G) ln_item(P, it, P.ln2_g + l * 2048, P.ln2_b + l * 2048, P.mod + (size_t)(l + 1) * 9 * 12288, 0, true, true);
            for (int rep = 0; rep < DUP_CV; ++rep) for (int t = 4 * c; t < CONV_TILES; t += 4 * G) conv_tile(P, l + 1, t, shm);
        } else {
            for (int it = c; it < NL / 8; it += G) ln_item(P, it, P.ln2_g + l * 2048, P.ln2_b + l * 2048, P.mod + (size_t)l * 9 * 12288, 0, false, false);
        }
    } break;
    }
}

__device__ __forceinline__ void grid_barrier(unsigned* cnt, unsigned target) {
    asm volatile("s_waitcnt vmcnt(0) lgkmcnt(0)" ::: "memory");
    __syncthreads();
    if (ltid() == 0) {
        __builtin_amdgcn_fence(__ATOMIC_RELEASE, "agent");
        asm volatile("s_waitcnt vmcnt(0)" ::: "memory");
        (void)__hip_atomic_fetch_add(cnt, 1u, __ATOMIC_RELAXED, __HIP_MEMORY_SCOPE_AGENT);
        unsigned spins = 0;
        while (__hip_atomic_load(cnt, __ATOMIC_RELAXED, __HIP_MEMORY_SCOPE_AGENT) < target) { __builtin_amdgcn_s_sleep(1); if (++spins > (1u << 22)) break; }
        __builtin_amdgcn_fence(__ATOMIC_ACQUIRE, "agent");
        asm volatile("s_waitcnt vmcnt(0)" ::: "memory");
    }
    __syncthreads();
}

#define XB_TMO      128
#define XB_XCNT(j)  (256  + 64 * (j))
#define XB_XSUB(j)  (1280 + 64 * (j))
#define XB_XGEN(j)  (2304 + 64 * (j))
#define XB_TOP      3328
#define XB_TOPGEN   3392
#define XCD_BAR_WORDS 3456
#define XB_SPIN_CAP (1u << 20)
__device__ __forceinline__ unsigned xb_ld(unsigned* p)              { return __hip_atomic_load(p, __ATOMIC_RELAXED, __HIP_MEMORY_SCOPE_AGENT); }
__device__ __forceinline__ unsigned xb_add(unsigned* p, unsigned v) { return __hip_atomic_fetch_add(p, v, __ATOMIC_RELAXED, __HIP_MEMORY_SCOPE_AGENT); }
__device__ __forceinline__ unsigned xb_xcc_id() { return (unsigned)__builtin_amdgcn_s_getreg((3 << 11) | 20) & 0xFu; }
#define XB_SPIN(cond, bar) do { unsigned _sp = 0; while (cond) { __builtin_amdgcn_s_sleep(1); \
    if ((++_sp & 255u) == 0u) { if (xb_ld(&(bar)[XB_TMO])) break; if (_sp > XB_SPIN_CAP) { atomicAdd(&(bar)[XB_TMO], 1u); break; } } } } while (0)
__device__ __forceinline__ void xcd_barrier_complete(unsigned* bar, unsigned x, unsigned& nloc, unsigned& nx) {
    const unsigned G = gridDim.x;
    unsigned sum, cnt, mine, sp = 0u;
    for (;;) {
        sum = 0u; cnt = 0u; mine = 0u;
#pragma unroll
        for (unsigned j = 0; j < 16; ++j) { const unsigned c = xb_ld(&bar[XB_XCNT(j)]); sum += c; cnt += (c > 0u) ? 1u : 0u; mine = (j == x) ? c : mine; }
        if (sum == G) break;
        __builtin_amdgcn_s_sleep(1);
        if ((++sp & 255u) == 0u) { if (xb_ld(&bar[XB_TMO])) break; if (sp > XB_SPIN_CAP) { atomicAdd(&bar[XB_TMO], 1u); break; } }
    }
    nloc = mine > 0u ? mine : 1u; nx = cnt > 0u ? cnt : 1u;
}
__device__ __forceinline__ void xcd_barrier(unsigned* bar, volatile LAS unsigned* st) {
    asm volatile("s_waitcnt vmcnt(0) lgkmcnt(0)" ::: "memory");
    __syncthreads();
    if (ltid() == 0) {
        const unsigned x = xb_xcc_id();
        unsigned nloc = st[0], nx = st[1];
        if (nloc == 0u) { xcd_barrier_complete(bar, x, nloc, nx); st[0] = nloc; st[1] = nx; }
        const unsigned old = xb_add(&bar[XB_XSUB(x)], 1u);
        const unsigned gen = old / nloc;
        if (old + 1u == (gen + 1u) * nloc) {
            __builtin_amdgcn_fence(__ATOMIC_RELEASE, "agent");
            asm volatile("s_waitcnt vmcnt(0)" ::: "memory");
            const unsigned og = xb_add(&bar[XB_TOP], 1u);
            const unsigned tg = og / nx;
            if (og + 1u == (tg + 1u) * nx) xb_add(&bar[XB_TOPGEN], 1u);
            else XB_SPIN(xb_ld(&bar[XB_TOPGEN]) == tg, bar);
            __builtin_amdgcn_fence(__ATOMIC_ACQUIRE, "agent");
            xb_add(&bar[XB_XGEN(x)], 1u);
            asm volatile("s_waitcnt vmcnt(0)" ::: "memory");
        } else {
            XB_SPIN(xb_ld(&bar[XB_XGEN(x)]) == gen, bar);
            __builtin_amdgcn_fence(__ATOMIC_ACQUIRE, "agent");
            asm volatile("s_waitcnt vmcnt(0)" ::: "memory");
        }
    }
    __syncthreads();
}

template <int PH> __device__ __forceinline__ void phase_chain(unsigned char* shm) {
    { const Params Pl = load_params(); run_phase(Pl, PH, shm); }
    if constexpr (PH + 1 < N_PHASES) {
        { const Params Pl = load_params(); xcd_barrier(Pl.bar, (volatile LAS unsigned*)(shm + LDS_BYTES)); }
        phase_chain<PH + 1>(shm);
    }
}
template <bool kCoop>
__global__ void __launch_bounds__(512, 2) mega_kernel(Params P, int ph0, int ph1) {
    extern __shared__ __attribute__((aligned(16))) unsigned char shm[];
    if (kCoop) {
        volatile LAS unsigned* st = (volatile LAS unsigned*)(shm + LDS_BYTES);
        { const Params Pl = load_params(); unsigned* bar0 = Pl.bar; const unsigned x0 = xb_xcc_id();
          if (ltid() == 0) { st[0] = 0u; st[1] = 0u; (void)xb_add(&bar0[XB_XCNT(x0)], 1u); } }
        __syncthreads();
        if (ph1 < 0) cg::this_grid().sync();
        phase_chain<0>(shm);
    }
    else { for (int ph = ph0; ph < ph1; ++ph) { const Params Pl = load_params(); run_phase(Pl, ph, shm); } }
}

extern "C" void kernel_launch(void* const* d_in, const int* in_sizes, int n_in, void* d_out, int out_size, void* d_ws, size_t ws_size, hipStream_t stream) {
    Params p{};
    const float* const* in = (const float* const*)d_in;
    p.x = in[0]; p.c = in[1]; p.ctx = in[2]; p.c_ctx = in[3]; p.w_ada = in[4]; p.b_ada = in[5]; p.w_in = in[6]; p.hgrn_lb = in[7]; p.hgrn_norm = in[8];
    p.pool_w = in[9]; p.pool_scale = in[10]; p.attn_sink = in[11]; p.w_branch = in[12]; p.w_out = in[13]; p.ln1_g = in[14]; p.ln1_b = in[15];
    p.w_ff1 = in[16]; p.w_ff2 = in[17]; p.ln2_g = in[18]; p.ln2_b = in[19];
    p.out = (float*)d_out;
    char* ws = (char*)d_ws; size_t off = 0;
    auto take = [&](size_t bytes) { char* r = ws + off; off += (bytes + 255) & ~(size_t)255; return r; };
    p.WinT = (bf16_t*)take((size_t)NCOLS * 2048 * 2); p.WbT = (bf16_t*)take((size_t)3 * 2048 * 1024 * 2); p.WoT = (bf16_t*)take((size_t)2048 * 2048 * 2);
    p.W1T = (bf16_t*)take((size_t)DFF * 2048 * 2); p.W2T = (bf16_t*)take((size_t)2048 * DFF * 2); p.PwT = (bf16_t*)take((size_t)4 * 65536 * 2);
    p.mod = (float*)take((size_t)2 * 9 * 12288 * 4); p.rope = (float*)take(4096 * 4); p.xc = (float*)take((size_t)2048 * 2048 * 4);
    p.bar = (unsigned*)take(XCD_BAR_WORDS * 4);
    p.stats = (float*)take((size_t)NT * 2 * 4);
    p.Qb = (bf16_t*)take(UNIT * 2);
    p.H = (bf16_t*)take((size_t)NT * 2048 * 2); p.U = (bf16_t*)take(UNIT * 2 * 27 / 2); p.Pd = (bf16_t*)take(UNIT * 2);
    if (off > ws_size) { fprintf(stderr, "workspace too small: need %zu have %zu\n", off, ws_size); return; }
#if COOP
    static int grid_blocks = 0;
    if (!grid_blocks) {
        (void)hipFuncSetAttribute((const void*)mega_kernel<true>, hipFuncAttributeMaxDynamicSharedMemorySize, LDS_BYTES + 16);
        int dev = 0, cus = 0, per_cu = 0;
        (void)hipGetDevice(&dev); (void)hipDeviceGetAttribute(&cus, hipDeviceAttributeMultiprocessorCount, dev);
        (void)hipOccupancyMaxActiveBlocksPerMultiprocessor(&per_cu, (const void*)mega_kernel<true>, 512, LDS_BYTES + 16);
        if (per_cu < 1) per_cu = 1; if (per_cu > 1) per_cu = 1;
        grid_blocks = cus > 0 ? cus * per_cu : 256; if (grid_blocks > 256) grid_blocks = 256;
    }
    int ph0 = 0, ph1 = N_PHASES;
    (void)hipMemsetAsync(p.bar, 0, XCD_BAR_WORDS * 4, stream);
    void* args[] = {&p, &ph0, &ph1};
    hipError_t e = hipLaunchCooperativeKernel((const void*)mega_kernel<true>, dim3(grid_blocks), dim3(512), args, LDS_BYTES + 16, stream);
    if (e != hipSuccess) fprintf(stderr, "cooperative launch failed: %s\n", hipGetErrorString(e));
#else
    static bool attr_set = false;
    if (!attr_set) { hipFuncSetAttribute((const void*)mega_kernel<false>, hipFuncAttributeMaxDynamicSharedMemorySize, LDS_BYTES); attr_set = true; }
    for (int ph = 0; ph < N_PHASES; ++ph) mega_kernel<false><<<256, 512, LDS_BYTES, stream>>>(p, ph, ph + 1);
#endif
}
```

```cpp
#include <hip/hip_runtime.h>
#include <hip/hip_cooperative_groups.h>
#include <cstdio>
namespace cg = cooperative_groups;

#ifndef COOP
#define COOP 1
#endif

#define LAS __attribute__((address_space(3)))
typedef unsigned short bf16_t;
typedef short bf16x8 __attribute__((ext_vector_type(8)));
typedef short bf16x4 __attribute__((ext_vector_type(4)));
typedef float f32x4 __attribute__((ext_vector_type(4)));
typedef float f32x16 __attribute__((ext_vector_type(16)));
typedef float f32x2 __attribute__((ext_vector_type(2)));
typedef unsigned u32x4 __attribute__((ext_vector_type(4)));
typedef unsigned u32x2 __attribute__((ext_vector_type(2)));

constexpr int NT = 18432, NL = 16384, DM = 2048, NCOLS = 13824, DFF = 8192;
constexpr size_t UNIT = (size_t)NT * 1024;
constexpr int LDS_BYTES = 131072;
constexpr float ALPHA = 1.41421356237f;
constexpr float QSCALE = 0.08838834764831845f * 1.4426950408889634f;
constexpr float LOG2E = 1.4426950408889634f;
constexpr int CONV_TILES = 6912 + 1536 + 1024 + 4096 + 4096 + 64;

struct Params {
    const float *x, *c, *ctx, *c_ctx, *w_ada, *b_ada, *w_in, *hgrn_lb, *hgrn_norm, *pool_w, *pool_scale, *attn_sink,
        *w_branch, *w_out, *ln1_g, *ln1_b, *w_ff1, *w_ff2, *ln2_g, *ln2_b;
    float* out;
    bf16_t *WinT, *WbT, *WoT, *W1T, *W2T, *PwT, *WinT1;
    float *mod, *rope, *xc;
    bf16_t *H, *U, *Pd, *Qb;
    unsigned* bar;
    float* stats;
};

#define AS4 __attribute__((address_space(4)))
__device__ __forceinline__ int ltid() { int t = __builtin_amdgcn_workitem_id_x(); asm volatile("" : "+v"(t)); return t; }
__device__ __forceinline__ int lbid() { int t = __builtin_amdgcn_workgroup_id_x(); asm volatile("" : "+s"(t)); return t; }
__device__ __forceinline__ float shx(float v, int lane, int mask) { return __int_as_float(__builtin_amdgcn_ds_bpermute((lane ^ mask) << 2, __float_as_int(v))); }
typedef __bf16 bf16v2_t __attribute__((ext_vector_type(2)));
__device__ __forceinline__ unsigned cvt_pk_bf16(float lo, float hi) { bf16v2_t v; v.x = (__bf16)lo; v.y = (__bf16)hi; return __builtin_bit_cast(unsigned, v); }
__device__ __forceinline__ float bf_lo(unsigned w) { return __uint_as_float(w << 16); }
__device__ __forceinline__ float bf_hi(unsigned w) { return __uint_as_float(w & 0xffff0000u); }
__device__ __forceinline__ u32x4 pack8(f32x4 a, f32x4 b) { u32x4 w; w.x = cvt_pk_bf16(a.x, a.y); w.y = cvt_pk_bf16(a.z, a.w); w.z = cvt_pk_bf16(b.x, b.y); w.w = cvt_pk_bf16(b.z, b.w); return w; }
__device__ __forceinline__ void unpack8(u32x4 w, f32x4& a, f32x4& b) { a.x = bf_lo(w.x); a.y = bf_hi(w.x); a.z = bf_lo(w.y); a.w = bf_hi(w.y); b.x = bf_lo(w.z); b.y = bf_hi(w.z); b.z = bf_lo(w.w); b.w = bf_hi(w.w); }
__device__ __forceinline__ float sigmoidf_(float v) { return __builtin_amdgcn_rcpf(1.0f + __builtin_amdgcn_exp2f(v * -1.4426950408889634f)); }
__device__ __forceinline__ float* xrow_ptr(const Params& P, size_t row) { return row < NL ? P.out + row * DM : P.xc + (row - NL) * DM; }

__device__ __forceinline__ Params load_params() {
    const AS4 Params* p = (const AS4 Params*)__builtin_amdgcn_kernarg_segment_ptr(); asm volatile("" : "+s"(p));
    Params r;
    r.x = p->x; r.c = p->c; r.ctx = p->ctx; r.c_ctx = p->c_ctx; r.w_ada = p->w_ada; r.b_ada = p->b_ada; r.w_in = p->w_in; r.hgrn_lb = p->hgrn_lb; r.hgrn_norm = p->hgrn_norm; r.pool_w = p->pool_w; r.pool_scale = p->pool_scale; r.attn_sink = p->attn_sink; r.w_branch = p->w_branch; r.w_out = p->w_out; r.ln1_g = p->ln1_g; r.ln1_b = p->ln1_b; r.w_ff1 = p->w_ff1; r.w_ff2 = p->w_ff2; r.ln2_g = p->ln2_g; r.ln2_b = p->ln2_b; r.out = p->out; r.WinT = p->WinT; r.WbT = p->WbT; r.WoT = p->WoT; r.W1T = p->W1T; r.W2T = p->W2T; r.PwT = p->PwT; r.WinT1 = p->WinT1; r.mod = p->mod; r.rope = p->rope; r.xc = p->xc; r.H = p->H; r.U = p->U; r.Pd = p->Pd; r.Qb = p->Qb; r.bar = p->bar; r.stats = p->stats;
    return r;
}

__device__ __forceinline__ void conv_tile(const Params& P, int l, int t, unsigned char* shm) {
    const float* src; bf16_t* dst; int K, N, kt, nt, perm = 0;
    if (t < 6912) { src = P.w_in + (size_t)l * 2048 * NCOLS; dst = l == 0 ? P.WinT : P.WinT1; K = 2048; N = NCOLS; kt = t / 216; nt = t % 216; perm = 1; }
    else if (t < 8448) { int u = t - 6912, j = u / 512; u %= 512; src = P.w_branch + ((size_t)l * 3 + j) * 1024 * 2048; dst = P.WbT + (size_t)j * 2048 * 1024; K = 1024; N = 2048; kt = u / 32; nt = u % 32; }
    else if (t < 9472) { int u = t - 8448; src = P.w_out + (size_t)l * 2048 * 2048; dst = P.WoT; K = 2048; N = 2048; kt = u / 32; nt = u % 32; }
    else if (t < 13568) { int u = t - 9472; src = P.w_ff1 + (size_t)l * 2048 * DFF; dst = P.W1T; K = 2048; N = DFF; kt = u / 128; nt = u % 128; }
    else if (t < 17664) { int u = t - 13568; src = P.w_ff2 + (size_t)l * DFF * 2048; dst = P.W2T; K = DFF; N = 2048; kt = u / 32; nt = u % 32; }
    else { int u = t - 17664, g = u / 16; u %= 16; src = P.pool_w + ((size_t)l * 4 + g) * 65536; dst = P.PwT + (size_t)g * 65536; K = 256; N = 256; kt = u / 4; nt = u % 4; }
    float* tile = (float*)shm;
    const int tid = ltid();
    float4 v[4][2];
#pragma unroll
    for (int q = 0; q < 4; ++q)
#pragma unroll
        for (int i = 0; i < 2; ++i) {
            const int r = (tid >> 4) + 32 * i, c4 = (tid & 15) * 4;
            v[q][i] = *(const float4*)(src + (size_t)(kt * 64 + r) * N + (nt + q) * 64 + c4);
        }
#pragma unroll
    for (int q = 0; q < 4; ++q)
#pragma unroll
        for (int i = 0; i < 2; ++i) {
            const int r = (tid >> 4) + 32 * i, c4 = (tid & 15) * 4; float* tp = tile + q * 4160 + r * 65 + c4;
            tp[0] = v[q][i].x; tp[1] = v[q][i].y; tp[2] = v[q][i].z; tp[3] = v[q][i].w;
        }
    __syncthreads();
#pragma unroll
    for (int q = 0; q < 4; ++q) {
        const int n = tid >> 3, kc = (tid & 7) * 8; const float* tp = tile + q * 4160;
        f32x4 a, b;
        a.x = tp[(kc + 0) * 65 + n]; a.y = tp[(kc + 1) * 65 + n]; a.z = tp[(kc + 2) * 65 + n]; a.w = tp[(kc + 3) * 65 + n];
        b.x = tp[(kc + 4) * 65 + n]; b.y = tp[(kc + 5) * 65 + n]; b.z = tp[(kc + 6) * 65 + n]; b.w = tp[(kc + 7) * 65 + n];
        int nd = (nt + q) * 64 + n;
        if (perm && nd >= 6144 && nd < 7424) {
            const int wi = nd - 6144, hd = wi >> 7, j = wi & 127;
            nd = 6144 + hd * 128 + 2 * (j & 63) + (j >> 6);
        }
        *(u32x4*)(dst + (size_t)nd * K + kt * 64 + kc) = pack8(a, b);
    }
    __syncthreads();
}

__device__ __forceinline__ void ada_item(const Params& P, int a, unsigned char* shm) {
    const int l = a / 96, j0 = (a % 96) * 128, tid = ltid(), w = tid >> 6, lane = tid & 63;
    float* sc = (float*)shm; float* red = sc + 9 * 2048;
    for (int idx = tid; idx < 9 * 2048; idx += 512) { const int r = idx >> 11, k = idx & 2047; const float cv = r < 8 ? P.c[r * 2048 + k] : P.c_ctx[k]; sc[idx] = cv / (1.0f + __expf(-cv)); }
    __syncthreads();
    f32x2 acc[9];
#pragma unroll
    for (int r = 0; r < 9; ++r) acc[r] = (f32x2){0.f, 0.f};
    const float* wp = P.w_ada + (size_t)l * 2048 * 12288 + (size_t)(w * 256) * 12288 + j0 + 2 * lane;
#pragma unroll 8
    for (int kk = 0; kk < 256; ++kk) {
        const f32x2 wv = *(const f32x2*)(wp + (size_t)kk * 12288);
#pragma unroll
        for (int r = 0; r < 9; ++r) acc[r] += wv * sc[r * 2048 + w * 256 + kk];
    }
#pragma unroll
    for (int r = 0; r < 9; ++r) { red[(w * 9 + r) * 128 + 2 * lane] = acc[r].x; red[(w * 9 + r) * 128 + 2 * lane + 1] = acc[r].y; }
    __syncthreads();
    for (int idx = tid; idx < 9 * 128; idx += 512) {
        const int r = idx >> 7, cc = idx & 127; float s = P.b_ada[l * 12288 + j0 + cc];
#pragma unroll
        for (int w2 = 0; w2 < 8; ++w2) s += red[(w2 * 9 + r) * 128 + cc];
        P.mod[(size_t)(l * 9 + r) * 12288 + j0 + cc] = s;
    }
    __syncthreads();
}

__device__ __forceinline__ void rope_item(const Params& P) {
    for (int idx = ltid(); idx < 2048; idx += 512) {
        const int pos = idx >> 5, f = idx & 31;
        const float invf = powf(10000.0f, -(float)f / 32.0f);
        const float angf = (float)pos * invf;
        double x = (double)angf; const double twopi = 6.283185307179586476925;
        x -= twopi * rint(x / twopi);
        const double x2 = x * x; double sn = x, cs = 1.0, ts = x, tc = 1.0;
        for (int k = 1; k <= 14; ++k) { tc *= -x2 / (double)((2 * k - 1) * (2 * k)); cs += tc; ts *= -x2 / (double)((2 * k) * (2 * k + 1)); sn += ts; }
        P.rope[idx] = (float)cs; P.rope[2048 + idx] = (float)sn;
    }
}

__device__ __forceinline__ void modulate0_item(const Params& P, int item) {
    const int w = ltid() >> 6, lane = ltid() & 63; const size_t row = (size_t)item * 8 + w;
    const float* src = row < NL ? P.x + row * DM : P.ctx + (row - NL) * DM;
    const int r = row < NL ? (int)(row >> 11) : 8;
    const float* sh = P.mod + (size_t)r * 12288; const float* sc = sh + 2048;
#pragma unroll
    for (int it = 0; it < 8; ++it) {
        const int col = it * 256 + lane * 4;
        const f32x4 xv = *(const f32x4*)(src + col), shv = *(const f32x4*)(sh + col), scv = *(const f32x4*)(sc + col);
        const f32x4 h = xv * (scv + 1.0f) + shv;
        u32x2 o; o.x = cvt_pk_bf16(h.x, h.y); o.y = cvt_pk_bf16(h.z, h.w);
        *(u32x2*)(P.H + row * DM + col) = o;
    }
}

__device__ __forceinline__ void ln_item(const Params& P, int item, const float* g, const float* bta, const float* modbase  , int shchunk, bool want_h, bool lazy) {
    const int w = ltid() >> 6, lane = ltid() & 63; const size_t row = (size_t)item * 8 + w;
    float* xp = xrow_ptr(P, row);
    f32x4 v[8]; float s = 0.f;
#pragma unroll
    for (int it = 0; it < 8; ++it) { v[it] = *(const f32x4*)(xp + it * 256 + lane * 4); s += v[it].x + v[it].y + v[it].z + v[it].w; }
#pragma unroll
    for (int o = 32; o >= 1; o >>= 1) s += shx(s, lane, o);
    const float mean = s * (1.0f / 2048.0f); float q = 0.f;
#pragma unroll
    for (int it = 0; it < 8; ++it) { const f32x4 d = v[it] - mean; q += d.x * d.x + d.y * d.y + d.z * d.z + d.w * d.w; }
#pragma unroll
    for (int o = 32; o >= 1; o >>= 1) q += shx(q, lane, o);
    const float rstd = rsqrtf(q * (1.0f / 2048.0f) + 1e-5f);
    if (lazy && lane == 0) { f32x2 st; st.x = mean; st.y = rstd; *(f32x2*)(P.stats + row * 2) = st; }
    const int r = row < NL ? (int)(row >> 11) : 8;
    const float* sh = modbase + (size_t)r * 12288 + shchunk * 2048; const float* sc = sh + 2048;
#pragma unroll
    for (int it = 0; it < 8; ++it) {
        const int col = it * 256 + lane * 4;
        const f32x4 y = (v[it] - mean) * rstd * *(const f32x4*)(g + col) + *(const f32x4*)(bta + col);
        if (!lazy) *(f32x4*)(xp + col) = y;
        if (want_h) {
            const f32x4 h = y * (*(const f32x4*)(sc + col) + 1.0f) + *(const f32x4*)(sh + col);
            u32x2 o; o.x = cvt_pk_bf16(h.x, h.y); o.y = cvt_pk_bf16(h.z, h.w);
            *(u32x2*)(P.H + row * DM + col) = o;
        }
    }
}

__device__ __forceinline__ void pooldiff_item(const Params& P, int item) {
    const int tid = ltid(); const size_t row = (size_t)item * 4 + (tid >> 7); const int col = (tid & 127) * 8;
    const int half = 1 << (col >> 8);
    int t, T; size_t base;
    if (row < NL) { t = (int)(row & 2047); T = 2048; base = row - t; } else { t = (int)((row - NL) & 255); T = 256; base = row - t; }
    const int lo = max(t - half, 0), hi = min(t + half, T);
    const bf16_t* ub = P.U + 5 * UNIT;
    f32x4 sa = {0.f, 0.f, 0.f, 0.f}, sb = sa;
    u32x4 wv[16];
#pragma unroll
    for (int k = 0; k < 16; ++k) { const int s = t - half + k; const bool ok = k < 2 * half && s >= 0 && s < T; wv[k] = ok ? *(const u32x4*)(ub + (base + (ok ? s : t)) * 1024 + col) : (u32x4){0u, 0u, 0u, 0u}; }
#pragma unroll
    for (int k = 0; k < 16; ++k) { f32x4 a, b; unpack8(wv[k], a, b); sa += a; sb += b; }
    f32x4 ma, mb; unpack8(*(const u32x4*)(ub + row * 1024 + col), ma, mb);
    const float inv = 1.0f / (float)(hi - lo);
    *(u32x4*)(P.Pd + row * 1024 + col) = pack8(sa * inv - ma, sb * inv - mb);
}

__device__ __forceinline__ void hgrn_final_item(const Params& P, int l, int item) {
    const int tid = ltid(); const size_t row = (size_t)item * 4 + (tid >> 7); const int col = (tid & 127) * 8;
    f32x4 fa, fb, ba, bb; unpack8(*(const u32x4*)(P.H + row * 1024 + col), fa, fb); unpack8(*(const u32x4*)(P.H + UNIT + row * 1024 + col), ba, bb);
    const f32x4 oa = fa + ba, ob = fb + bb;
    float ss = oa.x * oa.x + oa.y * oa.y + oa.z * oa.z + oa.w * oa.w + ob.x * ob.x + ob.y * ob.y + ob.z * ob.z + ob.w * ob.w;
#pragma unroll
    for (int o = 8; o >= 1; o >>= 1) ss += shx(ss, tid & 63, o);
    const float rms = rsqrtf(ss * (1.0f / 128.0f) + 1e-6f);
    bf16_t* yp = P.U + 4 * UNIT + row * 1024 + col;
    f32x4 ga, gb; unpack8(*(const u32x4*)yp, ga, gb);
    const float* ng = P.hgrn_norm + l * 1024 + col;
    *(u32x4*)yp = pack8(oa * rms * *(const f32x4*)ng * ga, ob * rms * *(const f32x4*)(ng + 4) * gb);
}

__device__ __forceinline__ void hgrn_item(const Params& P, int l, int item, unsigned char* shm) {
    const int vh = item & 1, dir = (item >> 1) & 1, h = (item >> 2) & 7, b = item >> 5;
    const int tid = ltid(), w = tid >> 6, lane = tid & 63;
    const bf16_t* Uq = P.U; const bf16_t* Ui = P.U + UNIT; const bf16_t* Kd = P.U + (2 + dir) * UNIT;
    bf16_t* O = P.H + (size_t)dir * UNIT;
    float* qs = (float*)shm; float* ks = qs + 32 * 128; float* vs = ks + 32 * 128; float* po = vs + 32 * 64;
    const int stok = tid >> 4, sch = tid & 15, vtok = (tid >> 3) & 31, vch = tid & 7;
    f32x4 omla, omlb;
    {
        float t8[8];
#pragma unroll
        for (int e = 0; e < 8; ++e) {
            const int j = dir * 1024 + h * 128 + sch * 8 + e;
            t8[e] = (l == 0) ? 1.0f : 1.0f - 1.0f / (1.0f + __expf(P.hgrn_lb[j] - P.hgrn_lb[2048 + j]));
        }
        omla = (f32x4){t8[0], t8[1], t8[2], t8[3]}; omlb = (f32x4){t8[4], t8[5], t8[6], t8[7]};
    }
    auto rowof = [&](int s) -> size_t {
        if (s < 256) return (size_t)NL + b * 256 + (dir ? 255 - s : s);
        const int u = s - 256; return (size_t)b * 2048 + (dir ? 2047 - u : u);
    };
    f32x2 S[8];
#pragma unroll
    for (int i = 0; i < 8; ++i) S[i] = (f32x2){0.f, 0.f};
    u32x4 rq, rk, rv = {0u, 0u, 0u, 0u};
    {
        const size_t r0 = rowof(stok);
        rq = *(const u32x4*)(Uq + r0 * 1024 + h * 128 + sch * 8); rk = *(const u32x4*)(Kd + r0 * 1024 + h * 128 + sch * 8);
        if (tid < 256) rv = *(const u32x4*)(Ui + rowof(vtok) * 1024 + h * 128 + vh * 64 + vch * 8);
    }
    for (int bt = 0; bt < 72; ++bt) {
        __syncthreads();
        {
            f32x4 a, c; unpack8(rq, a, c); *(f32x4*)(qs + stok * 128 + sch * 8) = a; *(f32x4*)(qs + stok * 128 + sch * 8 + 4) = c;
            unpack8(rk, a, c); *(f32x4*)(ks + stok * 128 + sch * 8) = a * omla; *(f32x4*)(ks + stok * 128 + sch * 8 + 4) = c * omlb;
            if (tid < 256) { unpack8(rv, a, c); *(f32x4*)(vs + vtok * 64 + vch * 8) = a; *(f32x4*)(vs + vtok * 64 + vch * 8 + 4) = c; }
        }
        __syncthreads();
        if (bt + 1 < 72) {
            const size_t r0 = rowof((bt + 1) * 32 + stok);
            rq = *(const u32x4*)(Uq + r0 * 1024 + h * 128 + sch * 8); rk = *(const u32x4*)(Kd + r0 * 1024 + h * 128 + sch * 8);
            if (tid < 256) rv = *(const u32x4*)(Ui + rowof((bt + 1) * 32 + vtok) * 1024 + h * 128 + vh * 64 + vch * 8);
        }
#pragma unroll 2
        for (int tok = 0; tok < 32; ++tok) {
            const f32x4* q4 = (const f32x4*)(qs + tok * 128 + w * 16); const f32x4* k4 = (const f32x4*)(ks + tok * 128 + w * 16);
            const f32x4 qa = q4[0], qb = q4[1], qc = q4[2], qd = q4[3], ka = k4[0], kb = k4[1], kc = k4[2], kd = k4[3];
            const float v = vs[tok * 64 + lane]; const f32x2 vv = {v, v};
            f32x2 o2;
            S[0] += (f32x2){ka.x, ka.y} * (vv - S[0]); o2 = S[0] * (f32x2){qa.x, qa.y};
            S[1] += (f32x2){ka.z, ka.w} * (vv - S[1]); o2 += S[1] * (f32x2){qa.z, qa.w};
            S[2] += (f32x2){kb.x, kb.y} * (vv - S[2]); o2 += S[2] * (f32x2){qb.x, qb.y};
            S[3] += (f32x2){kb.z, kb.w} * (vv - S[3]); o2 += S[3] * (f32x2){qb.z, qb.w};
            S[4] += (f32x2){kc.x, kc.y} * (vv - S[4]); o2 += S[4] * (f32x2){qc.x, qc.y};
            S[5] += (f32x2){kc.z, kc.w} * (vv - S[5]); o2 += S[5] * (f32x2){qc.z, qc.w};
            S[6] += (f32x2){kd.x, kd.y} * (vv - S[6]); o2 += S[6] * (f32x2){qd.x, qd.y};
            S[7] += (f32x2){kd.z, kd.w} * (vv - S[7]); o2 += S[7] * (f32x2){qd.z, qd.w};
            po[(w * 32 + tok) * 64 + lane] = o2.x + o2.y;
        }
        __syncthreads();
        {
            const int tok = tid >> 4, v4 = (tid & 15) * 4;
            f32x4 s = *(const f32x4*)(po + tok * 64 + v4);
#pragma unroll
            for (int w2 = 1; w2 < 8; ++w2) s += *(const f32x4*)(po + (w2 * 32 + tok) * 64 + v4);
            u32x2 o; o.x = cvt_pk_bf16(s.x, s.y); o.y = cvt_pk_bf16(s.z, s.w);
            *(u32x2*)(O + rowof(bt * 32 + tok) * 1024 + h * 128 + vh * 64 + v4) = o;
        }
    }
    __syncthreads();
}

__device__ __forceinline__ unsigned short f2bf1(float x) { return (unsigned short)(cvt_pk_bf16(x, 0.f) & 0xffffu); }
__device__ __forceinline__ void hgrn_chunk_item(const Params& P, int l, int item, unsigned char* shm) {
    const int vh = item & 1, dir = (item >> 1) & 1, h = (item >> 2) & 7, b = item >> 5;
    const int tid = ltid(), w = tid >> 6, lane = tid & 63, ql = lane & 31, hh = lane >> 5;
    const bf16_t* Uq = P.U + h * 128; const bf16_t* Ui = P.U + UNIT + h * 128 + vh * 64; const bf16_t* Kd = P.U + (2 + dir) * UNIT + h * 128;
    bf16_t* O = P.H + (size_t)dir * UNIT + h * 128 + vh * 64;
    bf16_t* Qt = (bf16_t*)shm;
    bf16_t* Kt = Qt + 32 * 136;
    bf16_t* KhT = Kt + 32 * 136;
    bf16_t* Vt = KhT + 128 * 40;
    bf16_t* St = Vt + 64 * 40;
    float* bC = (float*)(St + 64 * 136);
    float* tot = bC + 128;
    const int d = tid & 127, tq = tid >> 7, vv = tid & 63, tg = tid >> 6;
    float oml;
    { const int j = dir * 1024 + h * 128 + d; oml = (l == 0) ? 1.0f : 1.0f - 1.0f / (1.0f + __expf(P.hgrn_lb[j] - P.hgrn_lb[2048 + j])); }
    auto rowof = [&](int s) -> size_t {
        if (s < 256) return (size_t)NL + b * 256 + (dir ? 255 - s : s);
        const int u = s - 256; return (size_t)b * 2048 + (dir ? 2047 - u : u);
    };
    unsigned short rq[8], rk[8], rv[4];
    float qf[8], kf[8], pre[8]; u32x2 vhold = {0u, 0u};
    f32x16 Sacc;
#pragma unroll
    for (int r = 0; r < 16; ++r) Sacc[r] = 0.f;
    for (int i = tid; i < 64 * 136 * 2 / 16; i += 512) ((u32x4*)St)[i] = (u32x4){0u, 0u, 0u, 0u};
    const long rstep = dir ? -1024 : 1024;
#define HG_LOAD(c) do { const bf16_t* q_ = Uq + rowof((c) * 32 + tq * 8) * 1024 + d; const bf16_t* k_ = Kd + rowof((c) * 32 + tq * 8) * 1024 + d; \
        _Pragma("unroll") for (int e = 0; e < 8; ++e) { rq[e] = q_[e * rstep]; rk[e] = k_[e * rstep]; } \
        const bf16_t* v_ = Ui + rowof((c) * 32 + tg * 4) * 1024 + vv; \
        _Pragma("unroll") for (int e = 0; e < 4; ++e) rv[e] = v_[e * rstep]; } while (0)
#define HG_STEP1() do { float run_ = 1.f; _Pragma("unroll") for (int e = 0; e < 8; ++e) { qf[e] = __uint_as_float((unsigned)rq[e] << 16); kf[e] = oml * __uint_as_float((unsigned)rk[e] << 16); \
            run_ *= fmaxf(1.0f - kf[e], 6.1e-6f); pre[e] = run_; } tot[tq * 128 + d] = run_; \
        vhold.x = (unsigned)rv[0] | ((unsigned)rv[1] << 16); vhold.y = (unsigned)rv[2] | ((unsigned)rv[3] << 16); } while (0)
#define HG_STEP2() do { const float t0_ = tot[d], t1_ = tot[128 + d], t2_ = tot[256 + d], t3_ = tot[384 + d]; \
        const float off_ = (tq > 0 ? t0_ : 1.f) * (tq > 1 ? t1_ : 1.f) * (tq > 2 ? t2_ : 1.f), pc_ = (t0_ * t1_) * (t2_ * t3_); float kh_[8]; \
        _Pragma("unroll") for (int e = 0; e < 8; ++e) { const float p_ = fmaxf(off_ * pre[e], 1e-30f), rp_ = __builtin_amdgcn_rcpf(p_), kt_ = kf[e] * rp_; \
            Qt[(tq * 8 + e) * 136 + d] = f2bf1(qf[e] * p_); Kt[(tq * 8 + e) * 136 + d] = f2bf1(kt_); kh_[e] = kt_ * pc_; } \
        *(u32x4*)(KhT + d * 40 + tq * 8) = pack8((f32x4){kh_[0], kh_[1], kh_[2], kh_[3]}, (f32x4){kh_[4], kh_[5], kh_[6], kh_[7]}); \
        if (tq == 0) bC[d] = pc_; \
        *(u32x2*)(Vt + vv * 40 + tg * 4) = vhold; } while (0)
    HG_LOAD(0);
    HG_STEP1();
    __syncthreads();
    HG_STEP2();
    HG_LOAD(1);
    for (int c = 0; c < 72; ++c) {
        __syncthreads();
        if (c + 1 < 72) { HG_STEP1(); }
        if (c + 2 < 72) { HG_LOAD(c + 2); }
        if (w < 2) {
            const int vt = w;
            f32x16 X, Ot; bf16x8 qfr[8];
#pragma unroll
            for (int r = 0; r < 16; ++r) { X[r] = 0.f; Ot[r] = 0.f; }
#pragma unroll
            for (int ks = 0; ks < 8; ++ks) {
                const bf16x8 a = *(const bf16x8*)(Kt + ql * 136 + 16 * ks + 8 * hh);
                qfr[ks] = *(const bf16x8*)(Qt + ql * 136 + 16 * ks + 8 * hh);
                X = __builtin_amdgcn_mfma_f32_32x32x16_bf16(a, qfr[ks], X, 0, 0, 0);
            }
#pragma unroll
            for (int r = 0; r < 16; ++r) { const int sidx = (r & 3) + 8 * (r >> 2) + 4 * hh; if (sidx > ql) X[r] = 0.f; }
#pragma unroll
            for (int s2 = 0; s2 < 2; ++s2) {
                u32x4 pw; pw.x = cvt_pk_bf16(X[8 * s2 + 0], X[8 * s2 + 1]); pw.y = cvt_pk_bf16(X[8 * s2 + 2], X[8 * s2 + 3]); pw.z = cvt_pk_bf16(X[8 * s2 + 4], X[8 * s2 + 5]); pw.w = cvt_pk_bf16(X[8 * s2 + 6], X[8 * s2 + 7]);
                const bf16_t* vp = Vt + (32 * vt + ql) * 40 + 16 * s2 + 4 * hh;
                const u32x2 lo = *(const u32x2*)vp, hi2 = *(const u32x2*)(vp + 8);
                u32x4 aw; aw.x = lo.x; aw.y = lo.y; aw.z = hi2.x; aw.w = hi2.y;
                Ot = __builtin_amdgcn_mfma_f32_32x32x16_bf16(__builtin_bit_cast(bf16x8, aw), __builtin_bit_cast(bf16x8, pw), Ot, 0, 0, 0);
            }
#pragma unroll
            for (int ks = 0; ks < 8; ++ks) {
                const bf16x8 a = *(const bf16x8*)(St + (32 * vt + ql) * 136 + 16 * ks + 8 * hh);
                Ot = __builtin_amdgcn_mfma_f32_32x32x16_bf16(a, qfr[ks], Ot, 0, 0, 0);
            }
            bf16_t* op = O + rowof(c * 32 + ql) * 1024 + 32 * vt + 4 * hh;
#pragma unroll
            for (int rg = 0; rg < 4; ++rg) { u32x2 o; o.x = cvt_pk_bf16(Ot[4 * rg], Ot[4 * rg + 1]); o.y = cvt_pk_bf16(Ot[4 * rg + 2], Ot[4 * rg + 3]); *(u32x2*)(op + 8 * rg) = o; }
        }
        const int vt2 = w & 1, dt = w >> 1;
        {
            const float sc = bC[32 * dt + ql];
#pragma unroll
            for (int r = 0; r < 16; ++r) Sacc[r] *= sc;
#pragma unroll
            for (int ks = 0; ks < 2; ++ks) {
                const bf16x8 a = *(const bf16x8*)(Vt + (32 * vt2 + ql) * 40 + 16 * ks + 8 * hh);
                const bf16x8 bb = *(const bf16x8*)(KhT + (32 * dt + ql) * 40 + 16 * ks + 8 * hh);
                Sacc = __builtin_amdgcn_mfma_f32_32x32x16_bf16(a, bb, Sacc, 0, 0, 0);
            }
        }
        __syncthreads();
#pragma unroll
        for (int r = 0; r < 16; ++r) St[(32 * vt2 + (r & 3) + 8 * (r >> 2) + 4 * hh) * 136 + 32 * dt + ql] = f2bf1(Sacc[r]);
        if (c + 1 < 72) { HG_STEP2(); }
    }
    __syncthreads();
#undef HG_LOAD
#undef HG_STEP1
#undef HG_STEP2
}

__device__ __forceinline__ void hgrn_chunk128_item(const Params& P, int l, int item, unsigned char* shm) {
    const int dir = item & 1, h = (item >> 1) & 7, b = item >> 4;
    const int tid = ltid(), w = tid >> 6, lane = tid & 63, ql = lane & 31, hh = lane >> 5;
    const bf16_t* Uq = P.U + h * 128; const bf16_t* Ui = P.U + UNIT + h * 128; const bf16_t* Kd = P.U + (2 + dir) * UNIT + h * 128;
    bf16_t* O = P.H + (size_t)dir * UNIT + h * 128;
    bf16_t* Qt = (bf16_t*)shm;
    bf16_t* Kt = Qt + 32 * 136;
    bf16_t* KhT = Kt + 32 * 136;
    bf16_t* Vt = KhT + 128 * 40;
    bf16_t* St = Vt + 128 * 40;
    float* bC = (float*)(St + 128 * 136);
    float* tot = bC + 128;
    const int d = tid & 127, tq = tid >> 7, vv = d, tg = tq;
    float oml;
    { const int j = dir * 1024 + h * 128 + d; oml = (l == 0) ? 1.0f : 1.0f - 1.0f / (1.0f + __expf(P.hgrn_lb[j] - P.hgrn_lb[2048 + j])); }
    auto rowof = [&](int s) -> size_t {
        if (s < 256) return (size_t)NL + b * 256 + (dir ? 255 - s : s);
        const int u = s - 256; return (size_t)b * 2048 + (dir ? 2047 - u : u);
    };
    unsigned short rq[8], rk[8], rv[8];
    float qf[8], kf[8], pre[8]; u32x4 vhold = {0u, 0u, 0u, 0u};
    f32x16 Sacc, Sacc1;
#pragma unroll
    for (int r = 0; r < 16; ++r) { Sacc[r] = 0.f; Sacc1[r] = 0.f; }
    for (int i = tid; i < 128 * 136 * 2 / 16; i += 512) ((u32x4*)St)[i] = (u32x4){0u, 0u, 0u, 0u};
    const long rstep = dir ? -1024 : 1024;
#define HG_LOAD(c) do { const bf16_t* q_ = Uq + rowof((c) * 32 + tq * 8) * 1024 + d; const bf16_t* k_ = Kd + rowof((c) * 32 + tq * 8) * 1024 + d; \
        _Pragma("unroll") for (int e = 0; e < 8; ++e) { rq[e] = q_[e * rstep]; rk[e] = k_[e * rstep]; } \
        const bf16_t* v_ = Ui + rowof((c) * 32 + tg * 8) * 1024 + vv; \
        _Pragma("unroll") for (int e = 0; e < 8; ++e) rv[e] = v_[e * rstep]; } while (0)
#define HG_STEP1() do { float run_ = 1.f; _Pragma("unroll") for (int e = 0; e < 8; ++e) { qf[e] = __uint_as_float((unsigned)rq[e] << 16); kf[e] = oml * __uint_as_float((unsigned)rk[e] << 16); \
            run_ *= fmaxf(1.0f - kf[e], 6.1e-6f); pre[e] = run_; } tot[tq * 128 + d] = run_; \
        vhold.x = (unsigned)rv[0] | ((unsigned)rv[1] << 16); vhold.y = (unsigned)rv[2] | ((unsigned)rv[3] << 16); vhold.z = (unsigned)rv[4] | ((unsigned)rv[5] << 16); vhold.w = (unsigned)rv[6] | ((unsigned)rv[7] << 16); } while (0)
#define HG_STEP2() do { const float t0_ = tot[d], t1_ = tot[128 + d], t2_ = tot[256 + d], t3_ = tot[384 + d]; \
        const float off_ = (tq > 0 ? t0_ : 1.f) * (tq > 1 ? t1_ : 1.f) * (tq > 2 ? t2_ : 1.f), pc_ = (t0_ * t1_) * (t2_ * t3_); float kh_[8]; \
        _Pragma("unroll") for (int e = 0; e < 8; ++e) { const float p_ = fmaxf(off_ * pre[e], 1e-30f), rp_ = __builtin_amdgcn_rcpf(p_), kt_ = kf[e] * rp_; \
            Qt[(tq * 8 + e) * 136 + d] = f2bf1(qf[e] * p_); Kt[(tq * 8 + e) * 136 + d] = f2bf1(kt_); kh_[e] = kt_ * pc_; } \
        *(u32x4*)(KhT + d * 40 + tq * 8) = pack8((f32x4){kh_[0], kh_[1], kh_[2], kh_[3]}, (f32x4){kh_[4], kh_[5], kh_[6], kh_[7]}); \
        if (tq == 0) bC[d] = pc_; \
        *(u32x4*)(Vt + vv * 40 + tg * 8) = vhold; } while (0)
    HG_LOAD(0);
    HG_STEP1();
    __syncthreads();
    HG_STEP2();
    HG_LOAD(1);
    for (int c = 0; c < 72; ++c) {
        __syncthreads();
        if (c + 1 < 72) { HG_STEP1(); }
        if (c + 2 < 72) { HG_LOAD(c + 2); }
        if (w < 4) {
            const int vt = w;
            f32x16 X, Ot; bf16x8 qfr[8];
#pragma unroll
            for (int r = 0; r < 16; ++r) { X[r] = 0.f; Ot[r] = 0.f; }
#pragma unroll
            for (int ks = 0; ks < 8; ++ks) {
                const bf16x8 a = *(const bf16x8*)(Kt + ql * 136 + 16 * ks + 8 * hh);
                qfr[ks] = *(const bf16x8*)(Qt + ql * 136 + 16 * ks + 8 * hh);
                X = __builtin_amdgcn_mfma_f32_32x32x16_bf16(a, qfr[ks], X, 0, 0, 0);
            }
#pragma unroll
            for (int r = 0; r < 16; ++r) { const int sidx = (r & 3) + 8 * (r >> 2) + 4 * hh; if (sidx > ql) X[r] = 0.f; }
#pragma unroll
            for (int s2 = 0; s2 < 2; ++s2) {
                u32x4 pw; pw.x = cvt_pk_bf16(X[8 * s2 + 0], X[8 * s2 + 1]); pw.y = cvt_pk_bf16(X[8 * s2 + 2], X[8 * s2 + 3]); pw.z = cvt_pk_bf16(X[8 * s2 + 4], X[8 * s2 + 5]); pw.w = cvt_pk_bf16(X[8 * s2 + 6], X[8 * s2 + 7]);
                const bf16_t* vp = Vt + (32 * vt + ql) * 40 + 16 * s2 + 4 * hh;
                const u32x2 lo = *(const u32x2*)vp, hi2 = *(const u32x2*)(vp + 8);
                u32x4 aw; aw.x = lo.x; aw.y = lo.y; aw.z = hi2.x; aw.w = hi2.y;
                Ot = __builtin_amdgcn_mfma_f32_32x32x16_bf16(__builtin_bit_cast(bf16x8, aw), __builtin_bit_cast(bf16x8, pw), Ot, 0, 0, 0);
            }
#pragma unroll
            for (int ks = 0; ks < 8; ++ks) {
                const bf16x8 a = *(const bf16x8*)(St + (32 * vt + ql) * 136 + 16 * ks + 8 * hh);
                Ot = __builtin_amdgcn_mfma_f32_32x32x16_bf16(a, qfr[ks], Ot, 0, 0, 0);
            }
            bf16_t* op = O + rowof(c * 32 + ql) * 1024 + 32 * vt + 4 * hh;
#pragma unroll
            for (int rg = 0; rg < 4; ++rg) { u32x2 o; o.x = cvt_pk_bf16(Ot[4 * rg], Ot[4 * rg + 1]); o.y = cvt_pk_bf16(Ot[4 * rg + 2], Ot[4 * rg + 3]); *(u32x2*)(op + 8 * rg) = o; }
        }
        const int dt = w & 3, vtA = (w >> 2) * 2;
        {
            const float sc = bC[32 * dt + ql];
#pragma unroll
            for (int r = 0; r < 16; ++r) { Sacc[r] *= sc; Sacc1[r] *= sc; }
#pragma unroll
            for (int ks = 0; ks < 2; ++ks) {
                const bf16x8 bb = *(const bf16x8*)(KhT + (32 * dt + ql) * 40 + 16 * ks + 8 * hh);
                const bf16x8 a0 = *(const bf16x8*)(Vt + (32 * vtA + ql) * 40 + 16 * ks + 8 * hh);
                const bf16x8 a1 = *(const bf16x8*)(Vt + (32 * vtA + 32 + ql) * 40 + 16 * ks + 8 * hh);
                Sacc = __builtin_amdgcn_mfma_f32_32x32x16_bf16(a0, bb, Sacc, 0, 0, 0);
                Sacc1 = __builtin_amdgcn_mfma_f32_32x32x16_bf16(a1, bb, Sacc1, 0, 0, 0);
            }
        }
        __syncthreads();
#pragma unroll
        for (int r = 0; r < 16; ++r) {
            St[(32 * vtA + (r & 3) + 8 * (r >> 2) + 4 * hh) * 136 + 32 * dt + ql] = f2bf1(Sacc[r]);
            St[(32 * vtA + 32 + (r & 3) + 8 * (r >> 2) + 4 * hh) * 136 + 32 * dt + ql] = f2bf1(Sacc1[r]);
        }
        if (c + 1 < 72) { HG_STEP2(); }
    }
    __syncthreads();
#undef HG_LOAD
#undef HG_STEP1
#undef HG_STEP2
}

__device__ __forceinline__ void attn_item(const Params& P, int l, int item, unsigned char* shm) {
    int b, qb, kvh; bool isctx;
    if (item < 512) { b = item >> 6; qb = (item >> 1) & 31; kvh = item & 1; isctx = false; }
    else { const int it = item - 512; b = it >> 3; qb = (it >> 1) & 3; kvh = it & 1; isctx = true; }
    const int tid = ltid(), w = tid >> 6, lane = tid & 63, g = w >> 1, qsub = w & 1, ql = lane & 31, hh = lane >> 5;
    const int hq = kvh * 4 + g, tq = qb * 64 + qsub * 32 + ql;
    const size_t qrow = isctx ? (size_t)NL + b * 256 + tq : (size_t)b * 2048 + tq;
    const bf16_t* qp = P.Qb + qrow * 1024 + hq * 128;
    bf16_t* yp = P.U + 6 * UNIT + qrow * 1024 + hq * 128;
    const bf16_t* KV = P.U + 7 * UNIT;
    bf16x8 qf[8];
#pragma unroll
    for (int s = 0; s < 8; ++s) qf[s] = *(const bf16x8*)(qp + 16 * s + 8 * hh);
    float m = P.attn_sink[l * 8 + hq] * LOG2E, lsum = hh == 0 ? 1.0f : 0.0f;
    f32x16 O[4];
#pragma unroll
    for (int dt = 0; dt < 4; ++dt)
#pragma unroll
        for (int r = 0; r < 16; ++r) O[dt][r] = 0.f;
    int nlat = 0, kt0 = 0;
    if (!isctx) { const int lo = max(0, qb * 64 - 128), hi = min(2047, qb * 64 + 63 + 128); kt0 = lo >> 5; nlat = (hi >> 5) - kt0 + 1; }
    const int ntile = nlat + 8;
    const int skey = tid >> 4, sch = tid & 15;
    bf16_t* KsB = (bf16_t*)shm;
    bf16_t* VtB = KsB + 2 * 32 * 136;
    auto krow = [&](int i) -> size_t { return i < nlat ? (size_t)b * 2048 + (kt0 + i) * 32 + skey : (size_t)NL + b * 256 + (i - nlat) * 32 + skey; };
    u32x4 rk, rv;
    { const size_t r0 = krow(0); rk = *(const u32x4*)(KV + r0 * 512 + kvh * 128 + sch * 8); rv = *(const u32x4*)(KV + r0 * 512 + 256 + kvh * 128 + sch * 8); }
    for (int i = 0; i < ntile; ++i) {
        bf16_t* Ks = KsB + (i & 1) * 32 * 136; bf16_t* Vt = VtB + (i & 1) * 128 * 36;
        *(u32x4*)(Ks + skey * 136 + sch * 8) = rk;
        {
            bf16_t* vp = Vt + (sch * 8) * 36 + skey;
            vp[0 * 36] = (bf16_t)(rv.x & 0xffff); vp[1 * 36] = (bf16_t)(rv.x >> 16); vp[2 * 36] = (bf16_t)(rv.y & 0xffff); vp[3 * 36] = (bf16_t)(rv.y >> 16);
            vp[4 * 36] = (bf16_t)(rv.z & 0xffff); vp[5 * 36] = (bf16_t)(rv.z >> 16); vp[6 * 36] = (bf16_t)(rv.w & 0xffff); vp[7 * 36] = (bf16_t)(rv.w >> 16);
        }
        __syncthreads();
        if (i + 1 < ntile) { const size_t r0 = krow(i + 1); rk = *(const u32x4*)(KV + r0 * 512 + kvh * 128 + sch * 8); rv = *(const u32x4*)(KV + r0 * 512 + 256 + kvh * 128 + sch * 8); }
        f32x16 S;
#pragma unroll
        for (int r = 0; r < 16; ++r) S[r] = 0.f;
#pragma unroll
        for (int s = 0; s < 8; ++s) {
            const bf16x8 a = *(const bf16x8*)(Ks + ql * 136 + 16 * s + 8 * hh);
            S = __builtin_amdgcn_mfma_f32_32x32x16_bf16(a, qf[s], S, 0, 0, 0);
        }
        if (i < nlat) {
            const int kbase = (kt0 + i) * 32 + 4 * hh;
#pragma unroll
            for (int r = 0; r < 16; ++r) { const int sk = kbase + (r & 3) + 8 * (r >> 2); const int d = tq - sk; if (d > 128 || d < -128) S[r] = -INFINITY; }
        }
        float mt = S[0];
#pragma unroll
        for (int r = 1; r < 16; ++r) mt = fmaxf(mt, S[r]);
        mt = fmaxf(mt, shx(mt, lane, 32));
        const float mnew = fmaxf(m, mt), alpha = exp2f(m - mnew); m = mnew;
        float ps = 0.f;
#pragma unroll
        for (int r = 0; r < 16; ++r) { S[r] = exp2f(S[r] - mnew); ps += S[r]; }
        lsum = lsum * alpha + ps;
#pragma unroll
        for (int dt = 0; dt < 4; ++dt)
#pragma unroll
            for (int r = 0; r < 16; ++r) O[dt][r] *= alpha;
        bf16x8 pf[2];
#pragma unroll
        for (int s2 = 0; s2 < 2; ++s2) {
            u32x4 pw; pw.x = cvt_pk_bf16(S[8 * s2 + 0], S[8 * s2 + 1]); pw.y = cvt_pk_bf16(S[8 * s2 + 2], S[8 * s2 + 3]); pw.z = cvt_pk_bf16(S[8 * s2 + 4], S[8 * s2 + 5]); pw.w = cvt_pk_bf16(S[8 * s2 + 6], S[8 * s2 + 7]);
            pf[s2] = __builtin_bit_cast(bf16x8, pw);
        }
#pragma unroll
        for (int dt = 0; dt < 4; ++dt)
#pragma unroll
            for (int s2 = 0; s2 < 2; ++s2) {
                const bf16_t* vp = Vt + (32 * dt + ql) * 36 + 16 * s2 + 4 * hh;
                const u32x2 lo = *(const u32x2*)vp, hi2 = *(const u32x2*)(vp + 8);
                u32x4 aw; aw.x = lo.x; aw.y = lo.y; aw.z = hi2.x; aw.w = hi2.y;
                O[dt] = __builtin_amdgcn_mfma_f32_32x32x16_bf16(__builtin_bit_cast(bf16x8, aw), pf[s2], O[dt], 0, 0, 0);
            }
    }
    const float ltot = lsum + shx(lsum, lane, 32), inv = 1.0f / ltot;
#pragma unroll
    for (int dt = 0; dt < 4; ++dt)
#pragma unroll
        for (int rg = 0; rg < 4; ++rg) {
            u32x2 o; o.x = cvt_pk_bf16(O[dt][4 * rg] * inv, O[dt][4 * rg + 1] * inv); o.y = cvt_pk_bf16(O[dt][4 * rg + 2] * inv, O[dt][4 * rg + 3] * inv);
            *(u32x2*)(yp + 32 * dt + 8 * rg + 4 * hh) = o;
        }
    __syncthreads();
}

constexpr int BM = 256, BK = 64, HALF = 128, HTB = HALF * BK * 2, NXCD = 8, WGM = 8;
__device__ __forceinline__ int lds_byte(int r, int c) { const int st = (r >> 4) * 2 + (c >> 5), rr = r & 15, cc = c & 31, ob = rr * 64 + cc * 2; return st * 1024 + (ob ^ (((ob >> 9) & 1) << 5)); }
__device__ __forceinline__ void stage_rc(int b, int& R, int& C) { const int st = b / 1024, sb = b % 1024, swz = sb ^ (((sb >> 9) & 1) << 5); R = (st >> 1) * 16 + swz / 64; C = (st & 1) * 32 + (swz % 64) / 2; }
__device__ __forceinline__ int perm32(int rho) { const int n = rho >> 4, i = rho & 15; return 8 * (i >> 2) + 4 * n + (i & 3); }

enum { MODE_U = 0, MODE_POOL = 1, MODE_BRANCH = 2, MODE_RES1 = 3, MODE_FF1 = 4, MODE_RES2 = 5 };
struct Unit { int pm, pn, z; };
template <int MODE> struct GCfg;
template <> struct GCfg<MODE_U>      { static constexpr int lda = 2048, ldb = 2048, nN = NCOLS / 256, nZ = 1, zseq = 0, K = 2048; static constexpr size_t sAz = 0, sBz = 0; };
template <> struct GCfg<MODE_POOL>   { static constexpr int lda = 1024, ldb = 256, nN = 1, nZ = 4, zseq = 0, K = 256; static constexpr size_t sAz = 256, sBz = 65536; };
template <> struct GCfg<MODE_BRANCH> { static constexpr int lda = 1024, ldb = 1024, nN = 8, nZ = 3, zseq = 1, K = 1024; static constexpr size_t sAz = UNIT, sBz = (size_t)2048 * 1024; };
template <> struct GCfg<MODE_RES1>   { static constexpr int lda = 2048, ldb = 2048, nN = 8, nZ = 1, zseq = 0, K = 2048; static constexpr size_t sAz = 0, sBz = 0; };
template <> struct GCfg<MODE_FF1>    { static constexpr int lda = 2048, ldb = 2048, nN = DFF / 256, nZ = 1, zseq = 0, K = 2048; static constexpr size_t sAz = 0, sBz = 0; };
template <> struct GCfg<MODE_RES2>   { static constexpr int lda = DFF, ldb = DFF, nN = 8, nZ = 1, zseq = 0, K = DFF; static constexpr size_t sAz = 0, sBz = 0; };
template <int MODE> __device__ __forceinline__ bool next_unit(int nM, int i, int G, int c, Unit& u) {
    typedef GCfg<MODE> C;
    if (MODE == MODE_U && nM == 64) {
        const long L = (long)i * G + c;
        if (L >= 3456) {
            if (L >= 3568) return false;
            const int idx = (int)L - 3456, k = idx >> 3;
            u.pm = 64 + (idx & 7); u.pn = k < 4 ? 4 + k : (k < 12 ? 12 + (k - 4) : 28 + (k - 12)); u.z = 0; return true;
        }
    }
    constexpr int nNe = C::zseq ? C::nN : C::nN * C::nZ; const int nwg = nM * nNe;
    const int ti = C::zseq ? i / C::nZ : i;
    const long L = (long)ti * G + c; if (L >= nwg) return false;
    int wgid = (int)L; { const int q = nwg / NXCD, r = nwg % NXCD, xcd = wgid % NXCD, off = wgid / NXCD; wgid = (xcd < r ? xcd * (q + 1) : r * (q + 1) + (xcd - r) * q) + off; }
    const int nig = WGM * nNe, gid = wgid / nig, fm = gid * WGM, gsz = (nM - fm) < WGM ? (nM - fm) : WGM;
    u.pm = fm + ((wgid % nig) % gsz); const int pne = (wgid % nig) / gsz;
    if (C::zseq) { u.pn = pne; u.z = i % C::nZ; } else { u.pn = pne % C::nN; u.z = pne / C::nN; }
    return true;
}

template <int MODE> __device__ __forceinline__ void epilogue(const int l_in, const Unit& u_in, f32x4 (&acc)[2][2][4][2], int wr, int wc, int fr, int fq) {
    const AS4 Params* Pp = (const AS4 Params*)__builtin_amdgcn_kernarg_segment_ptr();
    int pm = u_in.pm, pn = u_in.pn, z = u_in.z, l = l_in;
    asm volatile("" : "+s"(Pp), "+s"(pm), "+s"(pn), "+s"(z), "+s"(l), "+s"(wr), "+s"(wc), "+v"(fr), "+v"(fq));
    const int row0 = pm * BM + wr * 64 + fr, cl = wc * 32 + 8 * fq;
    if (MODE == MODE_U) {
        bf16_t* U = Pp->U; const float* rope = Pp->rope;
        int kind, ld, colo; bf16_t* dst;
        if (pn < 8) { kind = 0; dst = U + (size_t)(pn >> 2) * UNIT; ld = 1024; colo = (pn & 3) * 256 + cl; }
        else if (pn < 12) { kind = 1; dst = U + 4 * UNIT; ld = 1024; colo = (pn & 3) * 256 + cl; }
        else if (pn < 20) { kind = 2; dst = U + (size_t)(2 + ((pn - 12) >> 2)) * UNIT; ld = 1024; colo = (pn & 3) * 256 + cl; }
        else if (pn < 24) { kind = 0; dst = U + 5 * UNIT; ld = 1024; colo = (pn & 3) * 256 + cl; }
        else if (pn < 28) { kind = 4; dst = Pp->Qb; ld = 1024; colo = (pn & 3) * 256 + cl; }
        else if (pn == 28) { kind = 5; dst = U + 7 * UNIT; ld = 512; colo = cl; }
        else if (pn == 29) { kind = 0; dst = U + 7 * UNIT; ld = 512; colo = 256 + cl; }
        else { kind = 3; dst = U + 7 * UNIT + (size_t)NT * 512; ld = 6144; colo = (pn - 30) * 256 + cl; }
        const bool latent = pm < 64;
#pragma unroll
        for (int ai = 0; ai < 2; ++ai)
#pragma unroll
            for (int m = 0; m < 4; ++m) {
                const int row = row0 + ai * HALF + m * 16;
                f32x4 cs = {1.f, 1.f, 1.f, 1.f}, sn = {0.f, 0.f, 0.f, 0.f};
                if (kind >= 4 && latent) {
                    const int t = row & 2047, pos = wc < 2 ? (t >> 6) : (t & 63), f = (16 * wc + 4 * fq) & 31;
                    cs = *(const f32x4*)(rope + pos * 32 + f); sn = *(const f32x4*)(rope + 2048 + pos * 32 + f);
                }
#pragma unroll
                for (int bj = 0; bj < 2; ++bj) {
                    f32x4 a = acc[ai][bj][m][0], b = acc[ai][bj][m][1];
                    if (kind == 1) {
#pragma unroll
                        for (int j = 0; j < 4; ++j) { a[j] = a[j] * sigmoidf_(a[j]); b[j] = b[j] * sigmoidf_(b[j]); }
                    } else if (kind == 2) {
#pragma unroll
                        for (int j = 0; j < 4; ++j) { a[j] = sigmoidf_(-a[j]); b[j] = sigmoidf_(-b[j]); }
                    } else if (kind == 3) {
#pragma unroll
                        for (int j = 0; j < 4; ++j) { a[j] = sigmoidf_(a[j]); b[j] = sigmoidf_(b[j]); }
                    } else if (kind >= 4) {
                        f32x4 ra, rb;
                        ra.x = a.x * cs.x - a.y * sn.x; ra.y = a.y * cs.x + a.x * sn.x; ra.z = a.z * cs.y - a.w * sn.y; ra.w = a.w * cs.y + a.z * sn.y;
                        rb.x = b.x * cs.z - b.y * sn.z; rb.y = b.y * cs.z + b.x * sn.z; rb.z = b.z * cs.w - b.w * sn.w; rb.w = b.w * cs.w + b.z * sn.w;
                        a = ra; b = rb;
                        if (kind == 4) { a *= QSCALE; b *= QSCALE; }
                    }
                    *(u32x4*)(dst + (size_t)row * ld + colo + bj * HALF) = pack8(a, b);
                }
            }
    } else if (MODE == MODE_FF1) {
        bf16_t* dst = Pp->U;
#pragma unroll
        for (int ai = 0; ai < 2; ++ai)
#pragma unroll
            for (int m = 0; m < 4; ++m)
#pragma unroll
                for (int bj = 0; bj < 2; ++bj) {
                    f32x4 a = acc[ai][bj][m][0], b = acc[ai][bj][m][1];
#pragma unroll
                    for (int j = 0; j < 4; ++j) { const float x = fmaxf(a[j], 0.f), y = fmaxf(b[j], 0.f); a[j] = x * x; b[j] = y * y; }
                    *(u32x4*)(dst + (size_t)(row0 + ai * HALF + m * 16) * DFF + pn * 256 + cl + bj * HALF) = pack8(a, b);
                }
    } else if (MODE == MODE_POOL) {
        bf16_t* dst = Pp->U + 5 * UNIT; const float* ps = Pp->pool_scale + l * 1024 + z * 256 + cl;
#pragma unroll
        for (int bj = 0; bj < 2; ++bj) {
            const f32x4 s0 = *(const f32x4*)(ps + bj * HALF), s1 = *(const f32x4*)(ps + bj * HALF + 4);
#pragma unroll
            for (int ai = 0; ai < 2; ++ai)
#pragma unroll
                for (int m = 0; m < 4; ++m)
                    *(u32x4*)(dst + (size_t)(row0 + ai * HALF + m * 16) * 1024 + z * 256 + cl + bj * HALF) = pack8(acc[ai][bj][m][0] * s0, acc[ai][bj][m][1] * s1);
        }
    } else if (MODE == MODE_BRANCH) {
        bf16_t* U = Pp->U; bf16_t* Hb = Pp->H;
        const bf16_t* G = U + 7 * UNIT + (size_t)NT * 512;
#pragma unroll
        for (int ai = 0; ai < 2; ++ai)
#pragma unroll
            for (int m = 0; m < 4; ++m)
#pragma unroll
                for (int bj = 0; bj < 2; ++bj) {
                    const size_t row = row0 + ai * HALF + m * 16; const int col = pn * 256 + cl + bj * HALF;
                    f32x4 ga, gb; unpack8(*(const u32x4*)(G + row * 6144 + z * 2048 + col), ga, gb);
                    if (z < 2) {
                        f32x4 na, nb; unpack8(*(const u32x4*)(G + row * 6144 + (z + 1) * 2048 + col), na, nb);
#pragma unroll
                        for (int j = 0; j < 4; ++j) { ga[j] *= __builtin_amdgcn_rcpf(fmaxf(na[j], 1e-30f)); gb[j] *= __builtin_amdgcn_rcpf(fmaxf(nb[j], 1e-30f)); }
                        acc[ai][bj][m][0] *= ga; acc[ai][bj][m][1] *= gb;
                    } else *(u32x4*)(Hb + row * DM + col) = pack8(acc[ai][bj][m][0] * ga, acc[ai][bj][m][1] * gb);
                }
    } else {
        constexpr int chunk = MODE == MODE_RES1 ? 2 : 5;
        const int r = pm < 64 ? (pm >> 3) : 8;
        const float* gp = Pp->mod + (size_t)(l * 9 + r) * 12288 + chunk * 2048 + pn * 256 + cl;
        const bool from_input = (l == 0 && chunk == 2);
        float* xb = pm < 64 ? Pp->out : Pp->xc - (size_t)NL * DM;
        const float* xin = from_input ? (pm < 64 ? Pp->x : Pp->ctx - (size_t)NL * DM) : xb;
        const float* st = Pp->stats;
        const float* lng = (MODE == MODE_RES1 ? Pp->ln2_g + (l - 1) * 2048 : Pp->ln1_g + l * 2048) + pn * 256 + cl;
        const float* lnb = (MODE == MODE_RES1 ? Pp->ln2_b + (l - 1) * 2048 : Pp->ln1_b + l * 2048) + pn * 256 + cl;
#pragma unroll
        for (int bj = 0; bj < 2; ++bj) {
            const f32x4 g0 = *(const f32x4*)(gp + bj * HALF), g1 = *(const f32x4*)(gp + bj * HALF + 4);
            f32x4 lg0 = {1.f, 1.f, 1.f, 1.f}, lg1 = lg0, lb0 = {0.f, 0.f, 0.f, 0.f}, lb1 = lb0;
            if (!from_input) { lg0 = *(const f32x4*)(lng + bj * HALF); lg1 = *(const f32x4*)(lng + bj * HALF + 4); lb0 = *(const f32x4*)(lnb + bj * HALF); lb1 = *(const f32x4*)(lnb + bj * HALF + 4); }
#pragma unroll
            for (int ai = 0; ai < 2; ++ai)
#pragma unroll
                for (int m = 0; m < 4; ++m) {
                    const size_t row = (size_t)(row0 + ai * HALF + m * 16), o = row * DM + pn * 256 + cl + bj * HALF;
                    f32x4 x0 = *(const f32x4*)(xin + o), x1 = *(const f32x4*)(xin + o + 4);
                    if (!from_input) { const f32x2 ms = *(const f32x2*)(st + row * 2); x0 = (x0 - ms.x) * ms.y * lg0 + lb0; x1 = (x1 - ms.x) * ms.y * lg1 + lb1; }
                    *(f32x4*)(xb + o) = x0 * ALPHA + g0 * acc[ai][bj][m][0]; *(f32x4*)(xb + o + 4) = x1 * ALPHA + g1 * acc[ai][bj][m][1];
                }
        }
    }
}

template <int MODE> __device__ __forceinline__ void gemm_phase(const Params& P, LAS unsigned char* lds, const int l, const int nM, const bf16_t* gA, const bf16_t* gBt, const int pm_off = 0, const int Gv = 0, const int cv = 0) {
    typedef GCfg<MODE> C;
    const int tid = ltid(), wid = __builtin_amdgcn_readfirstlane(tid >> 6), lane = tid & 63, wr = wid >> 2, wc = wid & 3, fr = lane & 15, fq = lane >> 4;
    constexpr int K = C::K, nt = K / BK; const int G = Gv ? Gv : (int)gridDim.x, c = Gv ? cv : lbid();
    unsigned voffA[2], voffB[2];
#pragma unroll
    for (int i = 0; i < 2; ++i) { int R, Cc; stage_rc(tid * 16 + i * 8192, R, Cc); const int Rb = (R & ~31) + perm32(R & 31);
        voffA[i] = (unsigned)(R * C::lda + Cc) * 2u; voffB[i] = (unsigned)(Rb * C::ldb + Cc) * 2u; }
    const size_t kstep = (size_t)(BK * 2);
    constexpr size_t hstepA = (size_t)HALF * C::lda * 2, hstepB = (size_t)HALF * C::ldb * 2;
    const unsigned ldsw = (unsigned)wid * 1024u;
    const int aoff = lds_byte(wr * 64 + fr, fq * 8), boff = lds_byte(wc * 32 + fr, fq * 8);
#define G_SA(b, h) (((b) * 2 + (h)) * HTB)
#define G_SB(b, h) ((4 + (b) * 2 + (h)) * HTB)
#define G_STAGE(bufoff, gbase, voff) do { _Pragma("unroll") for (int _i = 0; _i < 2; ++_i) \
        __builtin_amdgcn_global_load_lds((const unsigned*)((const char*)(gbase) + (voff)[_i]), (LAS unsigned*)(lds + (bufoff) + ldsw + _i * 8192), 16, 0, 0); } while (0)
#define G_LDA(dst, b, h) do { _Pragma("unroll") for (int m = 0; m < 4; ++m) _Pragma("unroll") for (int k = 0; k < 2; ++k) dst[m][k] = *(const LAS bf16x8*)(lds + G_SA(b, h) + aoff + m * 2048 + k * 1024); } while (0)
#define G_LDB(dst, b, h) do { _Pragma("unroll") for (int n = 0; n < 2; ++n) _Pragma("unroll") for (int k = 0; k < 2; ++k) dst[n][k] = *(const LAS bf16x8*)(lds + G_SB(b, h) + boff + n * 2048 + k * 1024); } while (0)
#define G_MMA(ai, bj, At, Bt) do { __builtin_amdgcn_s_setprio(1); _Pragma("unroll") for (int m = 0; m < 4; ++m) _Pragma("unroll") for (int n = 0; n < 2; ++n) _Pragma("unroll") for (int k = 0; k < 2; ++k) \
        acc[ai][bj][m][n] = __builtin_amdgcn_mfma_f32_16x16x32_bf16(Bt[n][k], At[m][k], acc[ai][bj][m][n], 0, 0, 0); __builtin_amdgcn_s_setprio(0); } while (0)
#define G_WAIT_V(n) asm volatile("s_waitcnt vmcnt(" #n ")" ::: "memory")
#define G_WAIT_L(n) asm volatile("s_waitcnt lgkmcnt(" #n ")" ::: "memory")
#define G_BAR __builtin_amdgcn_s_barrier()
#define G_SCHED __builtin_amdgcn_sched_barrier(0)
#define G_APTR(u) ((const char*)(gA + (size_t)(u).z * C::sAz + (size_t)(u).pm * BM * C::lda))
#define G_BPTR(u) ((const char*)(gBt + (size_t)(u).z * C::sBz + (size_t)(u).pn * BM * C::ldb))
    Unit cur, nxt; int ui = 0;
    if (!next_unit<MODE>(nM, 0, G, c, cur)) return;
    cur.pm += pm_off;
    f32x4 acc[2][2][4][2];
#pragma unroll
    for (int a = 0; a < 2; ++a)
#pragma unroll
        for (int b = 0; b < 2; ++b)
#pragma unroll
            for (int m = 0; m < 4; ++m)
#pragma unroll
                for (int n = 0; n < 2; ++n) acc[a][b][m][n] = (f32x4){0.f, 0.f, 0.f, 0.f};
    bf16x8 At[4][2], B0[2][2], B1[2][2];
    const char* cA = G_APTR(cur); const char* cB = G_BPTR(cur);
    G_STAGE(G_SB(0, 0), cB, voffB); G_STAGE(G_SA(0, 0), cA, voffA); G_STAGE(G_SB(0, 1), cB + hstepB, voffB); G_STAGE(G_SA(0, 1), cA + hstepA, voffA);
    if (wr == 1) G_BAR;
    G_WAIT_V(4); G_BAR;
    G_STAGE(G_SB(1, 0), cB + kstep, voffB); G_STAGE(G_SA(1, 0), cA + kstep, voffA); G_STAGE(G_SB(1, 1), cB + hstepB + kstep, voffB);
    G_WAIT_V(6); G_BAR;
    for (;;) {
        const bool has_next = next_unit<MODE>(nM, ui + 1, G, c, nxt); nxt.pm += pm_off;
        const char* nA = has_next ? G_APTR(nxt) : cA; const char* nB = has_next ? G_BPTR(nxt) : cB;
        for (int t = 0; t < nt; t += 2) {
            const bool last = (t == nt - 2);
            const char* a1 = cA + (size_t)(t + 1) * kstep;
            const char* a2 = last ? nA : cA + (size_t)(t + 2) * kstep; const char* b2 = last ? nB : cB + (size_t)(t + 2) * kstep;
            const char* a3 = a2 + kstep; const char* b3 = b2 + kstep;
            G_LDB(B0, 0, 0); G_SCHED; G_LDA(At, 0, 0); G_STAGE(G_SA(1, 1), a1 + hstepA, voffA);
            G_WAIT_L(8); G_BAR; G_WAIT_L(0); G_MMA(0, 0, At, B0); G_BAR; G_SCHED;
            G_LDB(B1, 0, 1); G_STAGE(G_SB(0, 0), b2, voffB);
            G_BAR; G_WAIT_L(0); G_MMA(0, 1, At, B1); G_BAR;
            G_LDA(At, 0, 1); G_STAGE(G_SA(0, 0), a2, voffA);
            G_BAR; G_WAIT_L(0); G_MMA(1, 0, At, B0); G_BAR; G_SCHED;
            G_STAGE(G_SB(0, 1), b2 + hstepB, voffB);
            G_WAIT_V(6); G_BAR; G_MMA(1, 1, At, B1); G_BAR;
            G_LDB(B0, 1, 0); G_SCHED; G_LDA(At, 1, 0); G_STAGE(G_SA(0, 1), a2 + hstepA, voffA);
            G_WAIT_L(8); G_BAR; G_WAIT_L(0); G_MMA(0, 0, At, B0); G_BAR; G_SCHED;
            G_LDB(B1, 1, 1); G_STAGE(G_SB(1, 0), b3, voffB);
            G_BAR; G_WAIT_L(0); G_MMA(0, 1, At, B1); G_BAR;
            G_LDA(At, 1, 1); G_STAGE(G_SA(1, 0), a3, voffA);
            G_BAR; G_WAIT_L(0); G_MMA(1, 0, At, B0); G_BAR; G_SCHED;
            G_STAGE(G_SB(1, 1), b3 + hstepB, voffB);
            G_WAIT_V(6); G_BAR; G_MMA(1, 1, At, B1); G_BAR;
        }
        epilogue<MODE>(l, cur, acc, wr, wc, fr, fq);
        if (!has_next) break;
        if (!(MODE == MODE_BRANCH && cur.z < 2)) {
#pragma unroll
            for (int a = 0; a < 2; ++a)
#pragma unroll
                for (int b = 0; b < 2; ++b)
#pragma unroll
                    for (int m = 0; m < 4; ++m)
#pragma unroll
                        for (int n = 0; n < 2; ++n) acc[a][b][m][n] = (f32x4){0.f, 0.f, 0.f, 0.f};
        }
        cur = nxt; cA = nA; cB = nB; ++ui;
    }
    G_WAIT_V(0);
    if (wr == 0) G_BAR;
    G_BAR;
#undef G_SA
#undef G_SB
#undef G_STAGE
#undef G_LDA
#undef G_LDB
#undef G_MMA
#undef G_WAIT_V
#undef G_WAIT_L
#undef G_BAR
#undef G_SCHED
#undef G_APTR
#undef G_BPTR
}

constexpr int N_PHASES = 21;
#ifndef DUP_CV
#define DUP_CV 1
#endif
#ifndef DUP_BAR
#define DUP_BAR 1
#endif
#ifndef DUP_BR
#define DUP_BR 1
#endif
#ifndef DUP_F1
#define DUP_F1 1
#endif
__device__ __forceinline__ void run_phase(const Params& P, int ph, unsigned char* shm) {
    const int G = gridDim.x, c = lbid();
#ifndef ONLY_SP
    if (ph == 0) {
        if (c == G - 1) rope_item(P);
        for (int a = c; a < 192; a += G) ada_item(P, a, shm);
        for (int rep = 0; rep < DUP_CV; ++rep) for (int t = 4 * c; t < CONV_TILES; t += 4 * G) conv_tile(P, 0, t, shm);
        return;
    }
    if (ph == 1) { for (int it = c; it < NT / 8; it += G) modulate0_item(P, it); return; }
#endif
#ifdef ONLY_SP
    const int l = (ph - 2) / 9, sp = ONLY_SP;
#else
    const int l = ph < 12 ? 0 : 1, sp = l == 0 ? ph - 2 : (ph - 12 < 8 ? ph - 12 : 9);
#endif
    const int rows = l == 0 ? NT : NL;
    LAS unsigned char* lds = (LAS unsigned char*)shm;
#ifndef PH_MASK
#define PH_MASK 0x1ff
#endif
#define EN(k) if (!((PH_MASK >> (k)) & 1)) break;
    switch (sp) {
#ifndef DUP_UG
#define DUP_UG 1
#endif
    case 0: { EN(0)
        gemm_phase<MODE_U>(P, lds, l, l == 0 ? NT / 256 : NL / 256, P.H, l == 0 ? P.WinT : P.WinT1);
        if (l == 0) {
            const int r = 3888 % G;
            const int c2 = r ? c - r : c, G2 = r ? G - r : G;
            if (c2 >= 0) for (int t = 4 * c2; t < 6912; t += 4 * G2) conv_tile(P, 1, t, shm);
        }
    } break;
    case 1: { EN(1)
#ifndef DUP_HGRN
#define DUP_HGRN 1
#endif
        #ifndef HGRN_CHUNK
#define HGRN_CHUNK 1
#endif
        const int nattn = l == 0 ? 576 : 512;
        if (G >= 256) {
            const int npd = rows / 4, npd_h = (npd * 45) / 100;
            if (c < 128) {
                hgrn_chunk128_item(P, l, c, shm);
                for (int it = c; it < npd_h; it += 128) pooldiff_item(P, it);
            } else {
                const int c2 = c - 128, G2 = G - 128;
                for (int it = c2; it < nattn; it += G2) attn_item(P, l, it, shm);
                for (int it = npd_h + c2; it < npd; it += G2) pooldiff_item(P, it);
            }
        } else {
            for (int it = c; it < 128; it += G) hgrn_chunk128_item(P, l, it, shm);
            for (int it = c; it < nattn; it += G) attn_item(P, l, it, shm);
            for (int it = c; it < rows / 4; it += G) pooldiff_item(P, it);
        }
    } break;
    case 2: { EN(2)
        for (int it = c; it < rows / 4; it += G) hgrn_final_item(P, l, it);
        gemm_phase<MODE_POOL>(P, lds, l, rows / 256, P.Pd, P.PwT);
    } break;
    case 3: EN(3) for (int rep = 0; rep < DUP_BR; ++rep) gemm_phase<MODE_BRANCH>(P, lds, l, rows / 256, P.U + 4 * UNIT, P.WbT); break;
    case 4: EN(4) gemm_phase<MODE_RES1>(P, lds, l, rows / 256, P.H, P.WoT); break;
    case 5: EN(5) for (int it = c; it < rows / 8; it += G) ln_item(P, it, P.ln1_g + l * 2048, P.ln1_b + l * 2048, P.mod + (size_t)l * 9 * 12288, 3, true, true); break;
    case 6: EN(6) for (int rep = 0; rep < DUP_F1; ++rep) gemm_phase<MODE_FF1>(P, lds, l, rows / 256, P.H, P.W1T); break;
    case 7: EN(7) gemm_phase<MODE_RES2>(P, lds, l, NL / 256, P.U, P.W2T); break;
    case 8: { EN(8)
        const int split = G >= 128 ? 64 : 0;
        if (split && c < split) gemm_phase<MODE_RES2>(P, lds, l, (NT - NL) / 256, P.U, P.W2T, NL / 256, split, c);
        else {
            if (!split) gemm_phase<MODE_RES2>(P, lds, l, (NT - NL) / 256, P.U, P.W2T, NL / 256);
            const int c2 = c - split, G2 = G - split;
            for (int it = c2; it < NL / 8; it += G2) ln_item(P, it, P.ln2_g + l * 2048, P.ln2_b + l * 2048, P.mod + (size_t)(l + 1) * 9 * 12288, 0, true, true);
        }
    } break;
    case 9: { EN(8)
        const bool more = l + 1 < 2;
        if (more) {
            for (int it = NL / 8 + c; it < NT / 8; it += G) ln_item(P, it, P.ln2_g + l * 2048, P.ln2_b + l * 2048, P.mod + (size_t)(l + 1) * 9 * 12288, 0, true, true);
            for (int t = 6912 + 4 * c; t < CONV_TILES; t += 4 * G) conv_tile(P, l + 1, t, shm);
        } else {
            for (int it = c; it < NL / 8; it += G) ln_item(P, it, P.ln2_g + l * 2048, P.ln2_b + l * 2048, P.mod + (size_t)l * 9 * 12288, 0, false, false);
        }
    } break;
    }
}

__device__ __forceinline__ void grid_barrier(unsigned* cnt, unsigned target) {
    asm volatile("s_waitcnt vmcnt(0) lgkmcnt(0)" ::: "memory");
    __syncthreads();
    if (ltid() == 0) {
        __builtin_amdgcn_fence(__ATOMIC_RELEASE, "agent");
        asm volatile("s_waitcnt vmcnt(0)" ::: "memory");
        (void)__hip_atomic_fetch_add(cnt, 1u, __ATOMIC_RELAXED, __HIP_MEMORY_SCOPE_AGENT);
        unsigned spins = 0;
        while (__hip_atomic_load(cnt, __ATOMIC_RELAXED, __HIP_MEMORY_SCOPE_AGENT) < target) { __builtin_amdgcn_s_sleep(1); if (++spins > (1u << 22)) break; }
        __builtin_amdgcn_fence(__ATOMIC_ACQUIRE, "agent");
        asm volatile("s_waitcnt vmcnt(0)" ::: "memory");
    }
    __syncthreads();
}

#define XB_TMO      128
#define XB_XCNT(j)  (256  + 64 * (j))
#define XB_XSUB(j)  (1280 + 64 * (j))
#define XB_XGEN(j)  (2304 + 64 * (j))
#define XB_TOP      3328
#define XB_TOPGEN   3392
#define XCD_BAR_WORDS 3456
#define XB_SPIN_CAP (1u << 20)
__device__ __forceinline__ unsigned xb_ld(unsigned* p)              { return __hip_atomic_load(p, __ATOMIC_RELAXED, __HIP_MEMORY_SCOPE_AGENT); }
__device__ __forceinline__ unsigned xb_add(unsigned* p, unsigned v) { return __hip_atomic_fetch_add(p, v, __ATOMIC_RELAXED, __HIP_MEMORY_SCOPE_AGENT); }
__device__ __forceinline__ unsigned xb_xcc_id() { return (unsigned)__builtin_amdgcn_s_getreg((3 << 11) | 20) & 0xFu; }
#define XB_SPIN(cond, bar) do { unsigned _sp = 0; while (cond) { __builtin_amdgcn_s_sleep(1); \
    if ((++_sp & 255u) == 0u) { if (xb_ld(&(bar)[XB_TMO])) break; if (_sp > XB_SPIN_CAP) { atomicAdd(&(bar)[XB_TMO], 1u); break; } } } } while (0)
__device__ __forceinline__ void xcd_barrier_complete(unsigned* bar, unsigned x, unsigned& nloc, unsigned& nx) {
    const unsigned G = gridDim.x;
    unsigned sum, cnt, mine, sp = 0u;
    for (;;) {
        sum = 0u; cnt = 0u; mine = 0u;
#pragma unroll
        for (unsigned j = 0; j < 16; ++j) { const unsigned c = xb_ld(&bar[XB_XCNT(j)]); sum += c; cnt += (c > 0u) ? 1u : 0u; mine = (j == x) ? c : mine; }
        if (sum == G) break;
        __builtin_amdgcn_s_sleep(1);
        if ((++sp & 255u) == 0u) { if (xb_ld(&bar[XB_TMO])) break; if (sp > XB_SPIN_CAP) { atomicAdd(&bar[XB_TMO], 1u); break; } }
    }
    nloc = mine > 0u ? mine : 1u; nx = cnt > 0u ? cnt : 1u;
}
__device__ __forceinline__ void xcd_barrier(unsigned* bar, volatile LAS unsigned* st) {
    asm volatile("s_waitcnt vmcnt(0) lgkmcnt(0)" ::: "memory");
    __syncthreads();
    if (ltid() == 0) {
        const unsigned x = xb_xcc_id();
        unsigned nloc = st[0], nx = st[1];
        if (nloc == 0u) { xcd_barrier_complete(bar, x, nloc, nx); st[0] = nloc; st[1] = nx; }
        const unsigned old = xb_add(&bar[XB_XSUB(x)], 1u);
        const unsigned gen = old / nloc;
        if (old + 1u == (gen + 1u) * nloc) {
            __builtin_amdgcn_fence(__ATOMIC_RELEASE, "agent");
            asm volatile("s_waitcnt vmcnt(0)" ::: "memory");
            const unsigned og = xb_add(&bar[XB_TOP], 1u);
            const unsigned tg = og / nx;
            if (og + 1u == (tg + 1u) * nx) xb_add(&bar[XB_TOPGEN], 1u);
            else XB_SPIN(xb_ld(&bar[XB_TOPGEN]) == tg, bar);
            __builtin_amdgcn_fence(__ATOMIC_ACQUIRE, "agent");
            xb_add(&bar[XB_XGEN(x)], 1u);
            asm volatile("s_waitcnt vmcnt(0)" ::: "memory");
        } else {
            XB_SPIN(xb_ld(&bar[XB_XGEN(x)]) == gen, bar);
            __builtin_amdgcn_fence(__ATOMIC_ACQUIRE, "agent");
            asm volatile("s_waitcnt vmcnt(0)" ::: "memory");
        }
    }
    __syncthreads();
}

template <int PH> __device__ __forceinline__ void phase_chain(unsigned char* shm) {
    { const Params Pl = load_params(); run_phase(Pl, PH, shm); }
    if constexpr (PH + 1 < N_PHASES) {
        { const Params Pl = load_params(); xcd_barrier(Pl.bar, (volatile LAS unsigned*)(shm + LDS_BYTES)); }
        phase_chain<PH + 1>(shm);
    }
}
template <bool kCoop>
__global__ void __launch_bounds__(512, 2) mega_kernel(Params P, int ph0, int ph1) {
    extern __shared__ __attribute__((aligned(16))) unsigned char shm[];
    if (kCoop) {
        volatile LAS unsigned* st = (volatile LAS unsigned*)(shm + LDS_BYTES);
        { const Params Pl = load_params(); unsigned* bar0 = Pl.bar; const unsigned x0 = xb_xcc_id();
          if (ltid() == 0) { st[0] = 0u; st[1] = 0u; (void)xb_add(&bar0[XB_XCNT(x0)], 1u); } }
        __syncthreads();
        if (ph1 < 0) cg::this_grid().sync();
        phase_chain<0>(shm);
    }
    else { for (int ph = ph0; ph < ph1; ++ph) { const Params Pl = load_params(); run_phase(Pl, ph, shm); } }
}

extern "C" void kernel_launch(void* const* d_in, const int* in_sizes, int n_in, void* d_out, int out_size, void* d_ws, size_t ws_size, hipStream_t stream) {
    Params p{};
    const float* const* in = (const float* const*)d_in;
    p.x = in[0]; p.c = in[1]; p.ctx = in[2]; p.c_ctx = in[3]; p.w_ada = in[4]; p.b_ada = in[5]; p.w_in = in[6]; p.hgrn_lb = in[7]; p.hgrn_norm = in[8];
    p.pool_w = in[9]; p.pool_scale = in[10]; p.attn_sink = in[11]; p.w_branch = in[12]; p.w_out = in[13]; p.ln1_g = in[14]; p.ln1_b = in[15];
    p.w_ff1 = in[16]; p.w_ff2 = in[17]; p.ln2_g = in[18]; p.ln2_b = in[19];
    p.out = (float*)d_out;
    char* ws = (char*)d_ws; size_t off = 0;
    auto take = [&](size_t bytes) { char* r = ws + off; off += (bytes + 255) & ~(size_t)255; return r; };
    p.WinT = (bf16_t*)take((size_t)NCOLS * 2048 * 2); p.WbT = (bf16_t*)take((size_t)3 * 2048 * 1024 * 2); p.WoT = (bf16_t*)take((size_t)2048 * 2048 * 2);
    p.W1T = (bf16_t*)take((size_t)DFF * 2048 * 2); p.W2T = (bf16_t*)take((size_t)2048 * DFF * 2); p.PwT = (bf16_t*)take((size_t)4 * 65536 * 2);
    p.mod = (float*)take((size_t)2 * 9 * 12288 * 4); p.rope = (float*)take(4096 * 4); p.xc = (float*)take((size_t)2048 * 2048 * 4);
    p.bar = (unsigned*)take(XCD_BAR_WORDS * 4);
    p.WinT1 = (bf16_t*)take((size_t)NCOLS * 2048 * 2);
    p.stats = (float*)take((size_t)NT * 2 * 4);
    p.Qb = (bf16_t*)take(UNIT * 2);
    p.H = (bf16_t*)take((size_t)NT * 2048 * 2); p.U = (bf16_t*)take(UNIT * 2 * 27 / 2); p.Pd = (bf16_t*)take(UNIT * 2);
    if (off > ws_size) { fprintf(stderr, "workspace too small: need %zu have %zu\n", off, ws_size); return; }
#if COOP
    static int grid_blocks = 0;
    if (!grid_blocks) {
        (void)hipFuncSetAttribute((const void*)mega_kernel<true>, hipFuncAttributeMaxDynamicSharedMemorySize, LDS_BYTES + 16);
        int dev = 0, cus = 0, per_cu = 0;
        (void)hipGetDevice(&dev); (void)hipDeviceGetAttribute(&cus, hipDeviceAttributeMultiprocessorCount, dev);
        (void)hipOccupancyMaxActiveBlocksPerMultiprocessor(&per_cu, (const void*)mega_kernel<true>, 512, LDS_BYTES + 16);
        if (per_cu < 1) per_cu = 1; if (per_cu > 1) per_cu = 1;
        grid_blocks = cus > 0 ? cus * per_cu : 256; if (grid_blocks > 256) grid_blocks = 256;
    }
    int ph0 = 0, ph1 = N_PHASES;
    (void)hipMemsetAsync(p.bar, 0, XCD_BAR_WORDS * 4, stream);
    void* args[] = {&p, &ph0, &ph1};
    hipError_t e = hipLaunchCooperativeKernel((const void*)mega_kernel<true>, dim3(grid_blocks), dim3(512), args, LDS_BYTES + 16, stream);
    if (e != hipSuccess) fprintf(stderr, "cooperative launch failed: %s\n", hipGetErrorString(e));
#else
    static bool attr_set = false;
    if (!attr_set) { hipFuncSetAttribute((const void*)mega_kernel<false>, hipFuncAttributeMaxDynamicSharedMemorySize, LDS_BYTES); attr_set = true; }
    for (int ph = 0; ph < N_PHASES; ++ph) mega_kernel<false><<<256, 512, LDS_BYTES, stream>>>(p, ph, ph + 1);
#endif
}
```
